# Optimizing an MI355X kernel written in HIP

```python
import jax, jax.numpy as jnp
from jax import lax
import numpy as np

D_MODEL = 1024
BATCH = 4
SEQ = 8192
DEPTH = 2

N_HEADS = 8
N_KV_HEADS = 2
HEAD_DIM = 64
GQA_GROUP = N_HEADS // N_KV_HEADS
ATTN_WIDTH = N_HEADS * HEAD_DIM
KV_WIDTH = N_KV_HEADS * HEAD_DIM
WINDOW = 128
BLOCK = 128
ROPE_THETA = 500000.0
ROT_DIM = HEAD_DIM // 4
POOL_SIZES = (2, 4, 8, 16)
POOL_WIDTH = D_MODEL // 2
POOL_GROUP = POOL_WIDTH // len(POOL_SIZES)
N_BRANCHES = 2
IN_WIDTH = ATTN_WIDTH + 2 * KV_WIDTH + POOL_WIDTH + N_BRANCHES * D_MODEL
D_FF = 2816
EPS = 1e-6

kernel_name = "hybrid_swa_pool_macaron_encoder"


def rms_norm(x, g):
    x32 = x.astype(jnp.float32)
    y = x32 * lax.rsqrt(jnp.mean(x32 * x32, axis=-1, keepdims=True) + EPS)
    return (y * g.astype(jnp.float32)).astype(x.dtype)


def swiglu(u, w1, w3, w2):
    return (jax.nn.silu(u @ w1) * (u @ w3)) @ w2


def rope_tables(s):
    inv_freq = 1.0 / (ROPE_THETA ** (jnp.arange(0, ROT_DIM, 2, dtype=jnp.float32) / ROT_DIM))
    ang = jnp.arange(s, dtype=jnp.float32)[:, None] * inv_freq[None, :]
    return jnp.cos(ang), jnp.sin(ang)


def partial_rope(t, cos, sin):
    half = ROT_DIM // 2
    t32 = t.astype(jnp.float32)
    t1 = t32[..., :half]
    t2 = t32[..., half:ROT_DIM]
    c = cos[None, :, None, :]
    s = sin[None, :, None, :]
    rot = jnp.concatenate([t1 * c - t2 * s, t2 * c + t1 * s, t32[..., ROT_DIM:]], axis=-1)
    return rot.astype(t.dtype)


def banded_blocks(t):
    b, s = t.shape[0], t.shape[1]
    nb = s // BLOCK
    tp = jnp.pad(t, ((0, 0), (BLOCK, BLOCK), (0, 0), (0, 0)))
    parts = [tp[:, i * BLOCK:i * BLOCK + s].reshape(b, nb, BLOCK, t.shape[2], t.shape[3]) for i in range(3)]
    return jnp.concatenate(parts, axis=2)


def windowed_gqa(q, k, v, sink):
    b, s = q.shape[0], q.shape[1]
    nb = s // BLOCK
    qb = q.reshape(b, nb, BLOCK, N_KV_HEADS, GQA_GROUP, HEAD_DIM)
    kb = banded_blocks(k)
    vb = banded_blocks(v)
    scores = jnp.einsum('bnqhgd,bnkhd->bhgnqk', qb, kb).astype(jnp.float32) * (HEAD_DIM ** -0.5)
    blk = jnp.arange(nb)[:, None, None]
    qpos = blk * BLOCK + jnp.arange(BLOCK)[None, :, None]
    kpos = blk * BLOCK - BLOCK + jnp.arange(3 * BLOCK)[None, None, :]
    valid = (jnp.abs(qpos - kpos) <= WINDOW) & (kpos >= 0) & (kpos < s)
    scores = jnp.where(valid, scores, -1e30)
    sink_logit = jnp.broadcast_to(
        sink.astype(jnp.float32).reshape(1, N_KV_HEADS, GQA_GROUP, 1, 1, 1), scores.shape[:-1] + (1,))
    probs = jax.nn.softmax(jnp.concatenate([scores, sink_logit], axis=-1), axis=-1)[..., :-1]
    out = jnp.einsum('bhgnqk,bnkhd->bnqhgd', probs.astype(v.dtype), vb)
    return out.reshape(b, s, ATTN_WIDTH)


def multiscale_pool(p, pool_w, pool_scale):
    b, s, _ = p.shape
    p32 = p.astype(jnp.float32)
    cs = jnp.concatenate([jnp.zeros((b, 1, POOL_WIDTH), jnp.float32), jnp.cumsum(p32, axis=1)], axis=1)
    t = jnp.arange(s)
    outs = []
    for gi, w in enumerate(POOL_SIZES):
        sl = slice(gi * POOL_GROUP, (gi + 1) * POOL_GROUP)
        lo = jnp.clip(t - w // 2, 0, s)
        hi = jnp.clip(t + w // 2, 0, s)
        cnt = (hi - lo).astype(jnp.float32)[None, :, None]
        csg = cs[..., sl]
        mean = (jnp.take(csg, hi, axis=1) - jnp.take(csg, lo, axis=1)) / cnt
        outs.append(mean - p32[..., sl])
    pooled = jnp.stack(outs, axis=2).astype(p.dtype)
    mixed = jnp.einsum('bsgc,gcd->bsgd', pooled, pool_w).reshape(b, s, POOL_WIDTH)
    return mixed * pool_scale


def token_mixer(u, w_in, b_gate, attn_sink, pool_w, pool_scale, w_br_attn, w_br_pool, w_out, cos, sin):
    b, s, _ = u.shape
    proj = u @ w_in
    splits = np.cumsum([ATTN_WIDTH, KV_WIDTH, KV_WIDTH, POOL_WIDTH, D_MODEL]).tolist()
    q, k, v, p, ga, gb = jnp.split(proj, splits, axis=-1)
    q = partial_rope(q.reshape(b, s, N_HEADS, HEAD_DIM), cos, sin)
    k = partial_rope(k.reshape(b, s, N_KV_HEADS, HEAD_DIM), cos, sin)
    v = v.reshape(b, s, N_KV_HEADS, HEAD_DIM)
    y_attn = windowed_gqa(q, k, v, attn_sink) @ w_br_attn
    y_pool = multiscale_pool(p, pool_w, pool_scale) @ w_br_pool
    gate_a = jax.nn.sigmoid(ga + b_gate[:D_MODEL])
    gate_b = jax.nn.sigmoid(gb + b_gate[D_MODEL:])
    return (gate_a * y_attn + gate_b * y_pool) @ w_out


def _w(key, shape, fan_in):
    return jax.random.normal(key, shape, jnp.float32) * (fan_in ** -0.5)


def _gain(key, shape):
    return 1.0 + 0.05 * jax.random.normal(key, shape, jnp.float32)


def setup_inputs(seed: int = 0) -> dict:
    key = jax.random.key(seed)
    ks = jax.random.split(key, 22)
    L = DEPTH
    return {
        "x": jax.random.normal(ks[0], (BATCH, SEQ, D_MODEL), jnp.float32),
        "ffn1_norm": _gain(ks[1], (L, D_MODEL)),
        "ffn1_w1": _w(ks[2], (L, D_MODEL, D_FF), D_MODEL),
        "ffn1_w3": _w(ks[3], (L, D_MODEL, D_FF), D_MODEL),
        "ffn1_w2": _w(ks[4], (L, D_FF, D_MODEL), D_FF),
        "mix_norm": _gain(ks[5], (L, D_MODEL)),
        "w_in": _w(ks[6], (L, D_MODEL, IN_WIDTH), D_MODEL),
        "b_gate": 0.02 * jax.random.normal(ks[7], (L, N_BRANCHES * D_MODEL), jnp.float32),
        "attn_sink": 0.5 * jax.random.normal(ks[8], (L, N_HEADS), jnp.float32),
        "pool_w": _w(ks[9], (L, len(POOL_SIZES), POOL_GROUP, POOL_GROUP), POOL_GROUP),
        "pool_scale": _gain(ks[10], (L, POOL_WIDTH)),
        "w_branch_attn": _w(ks[11], (L, ATTN_WIDTH, D_MODEL), ATTN_WIDTH),
        "w_branch_pool": _w(ks[12], (L, POOL_WIDTH, D_MODEL), POOL_WIDTH),
        "w_out": _w(ks[13], (L, D_MODEL, D_MODEL), D_MODEL),
        "ffn2_norm": _gain(ks[14], (L, D_MODEL)),
        "ffn2_w1": _w(ks[15], (L, D_MODEL, D_FF), D_MODEL),
        "ffn2_w3": _w(ks[16], (L, D_MODEL, D_FF), D_MODEL),
        "ffn2_w2": _w(ks[17], (L, D_FF, D_MODEL), D_FF),
        "final_norm": _gain(ks[18], (D_MODEL,)),
    }


def reference(x, ffn1_norm, ffn1_w1, ffn1_w3, ffn1_w2, mix_norm, w_in, b_gate, attn_sink, pool_w,
              pool_scale, w_branch_attn, w_branch_pool, w_out, ffn2_norm, ffn2_w1, ffn2_w3, ffn2_w2,
              final_norm):
    cos, sin = rope_tables(x.shape[1])
    h = x
    for l in range(DEPTH):
        h = h + 0.5 * swiglu(rms_norm(h, ffn1_norm[l]), ffn1_w1[l], ffn1_w3[l], ffn1_w2[l])
        h = h + token_mixer(rms_norm(h, mix_norm[l]), w_in[l], b_gate[l], attn_sink[l], pool_w[l],
                            pool_scale[l], w_branch_attn[l], w_branch_pool[l], w_out[l], cos, sin)
        h = h + 0.5 * swiglu(rms_norm(h, ffn2_norm[l]), ffn2_w1[l], ffn2_w3[l], ffn2_w2[l])
    return rms_norm(h, final_norm)
```

```cpp
#include <hip/hip_runtime.h>
#include <hip/hip_cooperative_groups.h>
#include <cstdio>
#include <cstdint>
namespace cg = cooperative_groups;
namespace pg8 {
#define PG8_LAS __attribute__((address_space(3)))
typedef unsigned short bf16_t;
typedef short bf16x8 __attribute__((ext_vector_type(8)));
typedef float f32x4 __attribute__((ext_vector_type(4)));
typedef unsigned u32x4 __attribute__((ext_vector_type(4)));
constexpr int BM = 256, BK = 64, HALF = 128, HTB = HALF * BK * 2  , STAGE_BYTES = 8 * HTB, NXCD = 8, WGM = 8;

__host__ __device__ __forceinline__ int lds_byte(int r, int c) { const int st = (r >> 4) * 2 + (c >> 5), rr = r & 15, cc = c & 31, ob = rr * 64 + cc * 2; return st * 1024 + (ob ^ (((ob >> 9) & 1) << 5)); }
__host__ __device__ __forceinline__ void stage_rc(int b, int& R, int& C) { const int st = b / 1024, sb = b % 1024, swz = sb ^ (((sb >> 9) & 1) << 5); R = (st >> 1) * 16 + swz / 64; C = (st & 1) * 32 + (swz % 64) / 2; }
__host__ __device__ __forceinline__ int perm32(int rho) { const int n = rho >> 4, i = rho & 15; return 8 * (i >> 2) + 4 * n + (i & 3); }

struct Unit { int pm, pn; };
struct Gemm { const bf16_t* A; const bf16_t* Bt; int M, N, K; size_t a_gap = 0; };

struct StaticOrder {
    int nM, nN, nwg, G, c;
    __host__ __device__ void init(int M, int N, int G_, int c_) { nM = M / BM; nN = N / BM; nwg = nM * nN; G = G_; c = c_; }
    __host__ __device__ bool next(int i, Unit& u) const {
        const long L = (long)i * G + c; if (L >= nwg) return false;
        int wgid = (int)L; { const int q = nwg / NXCD, r = nwg % NXCD, xcd = wgid % NXCD, off = wgid / NXCD; wgid = (xcd < r ? xcd * (q + 1) : r * (q + 1) + (xcd - r) * q) + off; }
        const int nig = WGM * nN, gid = wgid / nig, fm = gid * WGM, gsz = (nM - fm) < WGM ? (nM - fm) : WGM;
        u.pm = fm + ((wgid % nig) % gsz); u.pn = (wgid % nig) / gsz; return true;
    }
    __device__ __forceinline__ void a_ready(const Unit&) const {}
    __device__ __forceinline__ void done(const Unit&) const {}
};
__device__ __forceinline__ unsigned cvt_pk_bf16(float lo, float hi) { unsigned r; asm volatile("v_cvt_pk_bf16_f32 %0, %1, %2" : "=v"(r) : "v"(lo), "v"(hi)); return r; }
typedef float f32x2 __attribute__((ext_vector_type(2)));
#define PG8_GAS __attribute__((address_space(1)))
__device__ __forceinline__ float bf_lo(unsigned w) { return __uint_as_float(w << 16); }
__device__ __forceinline__ float bf_hi(unsigned w) { return __uint_as_float(w & 0xffff0000u); }
__device__ __forceinline__ float sigmoid_fast(float v) { return __builtin_amdgcn_rcpf(1.0f + __expf(-v)); }
__device__ __forceinline__ void rows_rstd(const PG8_LAS float* rst, int pm, int wr, int fr, float (&rs)[2][4]) {
    const PG8_LAS float* t = rst + ((pm >> 3) & 3) * 256 + wr * 64 + fr;
#pragma unroll
    for (int ai = 0; ai < 2; ++ai)
#pragma unroll
        for (int m = 0; m < 4; ++m) rs[ai][m] = t[ai * HALF + m * 16];
}
struct EpiNull {
    static constexpr bool PERM = true, AFTER_DRAIN = false;
    float* sink;
    __device__ __forceinline__ void operator()(const f32x4 (&acc)[2][2][4][2], const Unit& u, int wr, int wc, int fr, int fq) const {
        float s = 0.f;
#pragma unroll
        for (int ai = 0; ai < 2; ++ai)
#pragma unroll
            for (int bj = 0; bj < 2; ++bj)
#pragma unroll
                for (int m = 0; m < 4; ++m)
#pragma unroll
                    for (int n = 0; n < 2; ++n) s += acc[ai][bj][m][n][0];
        if (s == 1.2345e-33f) *sink = s;
    }
};
struct EpiUp {
    static constexpr bool PERM = true, AFTER_DRAIN = false;
    bf16_t* G; const PG8_LAS float* rst; int ldg; size_t xgap;
    __device__ __forceinline__ void operator()(const f32x4 (&acc)[2][2][4][2], const Unit& u, int wr, int wc, int fr, int fq) const {
        const int row0 = u.pm * BM + wr * 64 + fr, col0 = u.pn * HALF + wc * 32 + 8 * fq;
        float rs[2][4]; rows_rstd(rst, u.pm, wr, fr, rs);
#pragma unroll
        for (int ai = 0; ai < 2; ++ai)
#pragma unroll
            for (int m = 0; m < 4; ++m) {
                const int row = row0 + ai * HALF + m * 16; const float r = rs[ai][m], kk = r * -1.4426950408889634f, r2 = r * r;
                f32x4 o[2];
#pragma unroll
                for (int n = 0; n < 2; ++n) {
                    const f32x4 a = acc[ai][0][m][n], b = acc[ai][1][m][n];
                    const f32x4 t = a * kk;
                    f32x4 e; e[0] = __builtin_amdgcn_exp2f(t[0]); e[1] = __builtin_amdgcn_exp2f(t[1]); e[2] = __builtin_amdgcn_exp2f(t[2]); e[3] = __builtin_amdgcn_exp2f(t[3]);
                    const f32x4 d = e + 1.0f;
                    f32x4 q; q[0] = __builtin_amdgcn_rcpf(d[0]); q[1] = __builtin_amdgcn_rcpf(d[1]); q[2] = __builtin_amdgcn_rcpf(d[2]); q[3] = __builtin_amdgcn_rcpf(d[3]);
                    o[n] = (a * b) * (q * r2);
                }
                u32x4 w; w.x = cvt_pk_bf16(o[0][0], o[0][1]); w.y = cvt_pk_bf16(o[0][2], o[0][3]); w.z = cvt_pk_bf16(o[1][0], o[1][1]); w.w = cvt_pk_bf16(o[1][2], o[1][3]);
                *(PG8_GAS u32x4*)(G + (size_t)row * ldg + (size_t)(row >> 12) * xgap + col0) = w;
            }
    }
};
struct EpiIn {
    static constexpr bool PERM = true, AFTER_DRAIN = false;
    bf16_t* P; const PG8_LAS float* rst; const PG8_LAS float* bgate; int ldp, gate0, pnoff;
    __device__ __forceinline__ void operator()(const f32x4 (&acc)[2][2][4][2], const Unit& u, int wr, int wc, int fr, int fq) const {
        const int row0 = u.pm * BM + wr * 64 + fr, col0 = (u.pn + pnoff) * BM + wc * 32 + 8 * fq;
        const bool gate = ((u.pn + pnoff) * BM >= gate0);
        float rs[2][4]; rows_rstd(rst, u.pm, wr, fr, rs);
        f32x4 bv[2][2];
#pragma unroll
        for (int bj = 0; bj < 2; ++bj)
#pragma unroll
            for (int n = 0; n < 2; ++n) bv[bj][n] = gate ? *(const PG8_LAS f32x4*)(bgate + (col0 - gate0) + bj * HALF + 4 * n) : (f32x4){0.f, 0.f, 0.f, 0.f};
#pragma unroll
        for (int ai = 0; ai < 2; ++ai)
#pragma unroll
            for (int m = 0; m < 4; ++m) {
                const int row = row0 + ai * HALF + m * 16; const float r = rs[ai][m];
#pragma unroll
                for (int bj = 0; bj < 2; ++bj) {
                    f32x4 v0 = acc[ai][bj][m][0] * r + bv[bj][0], v1 = acc[ai][bj][m][1] * r + bv[bj][1];
                    if (gate) {
                        const f32x4 t0 = v0 * -1.4426950408889634f, t1 = v1 * -1.4426950408889634f;
                        f32x4 e0, e1;
#pragma unroll
                        for (int j = 0; j < 4; ++j) { e0[j] = __builtin_amdgcn_exp2f(t0[j]); e1[j] = __builtin_amdgcn_exp2f(t1[j]); }
                        const f32x4 d0 = e0 + 1.0f, d1 = e1 + 1.0f;
#pragma unroll
                        for (int j = 0; j < 4; ++j) { v0[j] = __builtin_amdgcn_rcpf(d0[j]); v1[j] = __builtin_amdgcn_rcpf(d1[j]); }
                    }
                    u32x4 w; w.x = cvt_pk_bf16(v0[0], v0[1]); w.y = cvt_pk_bf16(v0[2], v0[3]); w.z = cvt_pk_bf16(v1[0], v1[1]); w.w = cvt_pk_bf16(v1[2], v1[3]);
                    *(PG8_GAS u32x4*)(P + (size_t)row * ldp + col0 + bj * HALF) = w;
                }
            }
    }
};
struct EpiRes {
    static constexpr bool PERM = true, AFTER_DRAIN = false;
    const float* resf; bf16_t* hb; float* ssq; float alpha;
    __device__ __forceinline__ void operator()(const f32x4 (&acc)[2][2][4][2], const Unit& u, int wr, int wc, int fr, int fq) const {
        const int row0 = u.pm * BM + wr * 64 + fr, col0 = u.pn * BM + wc * 32 + 8 * fq;
        if (resf) {
#pragma unroll
            for (int ai = 0; ai < 2; ++ai)
#pragma unroll
                for (int m = 0; m < 4; ++m) {
                    const int row = row0 + ai * HALF + m * 16; const size_t off = (size_t)row * 1024 + col0;
                    float q = 0.f;
#pragma unroll
                    for (int bj = 0; bj < 2; ++bj) {
                        const f32x4 r0 = *(const PG8_GAS f32x4*)(resf + off + bj * HALF), r1 = *(const PG8_GAS f32x4*)(resf + off + bj * HALF + 4);
                        const f32x4 o0 = r0 + acc[ai][bj][m][0] * alpha, o1 = r1 + acc[ai][bj][m][1] * alpha;
                        u32x4 w; w.x = cvt_pk_bf16(o0[0], o0[1]); w.y = cvt_pk_bf16(o0[2], o0[3]); w.z = cvt_pk_bf16(o1[0], o1[1]); w.w = cvt_pk_bf16(o1[2], o1[3]);
                        *(PG8_GAS u32x4*)(hb + off + bj * HALF) = w;
                        q += (o0[0] * o0[0] + o0[1] * o0[1]) + (o0[2] * o0[2] + o0[3] * o0[3]) + (o1[0] * o1[0] + o1[1] * o1[1]) + (o1[2] * o1[2] + o1[3] * o1[3]);
                    }
                    q += __shfl_xor(q, 16); q += __shfl_xor(q, 32);
                    if (fq == 0) ssq[(size_t)row * 16 + u.pn * 4 + wc] = q;
                    if (m == 3) asm volatile("" ::: "memory");
                }
        } else {
#pragma unroll
            for (int ai = 0; ai < 2; ++ai) {
                u32x4 hw[4][2];
#pragma unroll
                for (int m = 0; m < 4; ++m)
#pragma unroll
                    for (int bj = 0; bj < 2; ++bj) hw[m][bj] = *(const PG8_GAS u32x4*)(hb + (size_t)(row0 + ai * HALF + m * 16) * 1024 + col0 + bj * HALF);
#pragma unroll
                for (int m = 0; m < 4; ++m) {
                    const int row = row0 + ai * HALF + m * 16; const size_t off = (size_t)row * 1024 + col0;
                    float q = 0.f;
#pragma unroll
                    for (int bj = 0; bj < 2; ++bj) {
                        const u32x4 h = hw[m][bj]; const f32x4 a0 = acc[ai][bj][m][0], a1 = acc[ai][bj][m][1];
                        float o[8];
                        o[0] = bf_lo(h.x) + a0[0] * alpha; o[1] = bf_hi(h.x) + a0[1] * alpha; o[2] = bf_lo(h.y) + a0[2] * alpha; o[3] = bf_hi(h.y) + a0[3] * alpha;
                        o[4] = bf_lo(h.z) + a1[0] * alpha; o[5] = bf_hi(h.z) + a1[1] * alpha; o[6] = bf_lo(h.w) + a1[2] * alpha; o[7] = bf_hi(h.w) + a1[3] * alpha;
                        u32x4 w; w.x = cvt_pk_bf16(o[0], o[1]); w.y = cvt_pk_bf16(o[2], o[3]); w.z = cvt_pk_bf16(o[4], o[5]); w.w = cvt_pk_bf16(o[6], o[7]);
                        *(PG8_GAS u32x4*)(hb + off + bj * HALF) = w;
                        q += (o[0] * o[0] + o[1] * o[1]) + (o[2] * o[2] + o[3] * o[3]) + (o[4] * o[4] + o[5] * o[5]) + (o[6] * o[6] + o[7] * o[7]);
                    }
                    q += __shfl_xor(q, 16); q += __shfl_xor(q, 32);
                    if (fq == 0) ssq[(size_t)row * 16 + u.pn * 4 + wc] = q;
                }
                asm volatile("" ::: "memory");
            }
        }
    }
};
template <bool FIRST> struct EpiBr {
    static constexpr bool PERM = true, AFTER_DRAIN = false;
    const bf16_t* P; bf16_t* Z; int ldp, goff;
    __device__ __forceinline__ void operator()(const f32x4 (&acc)[2][2][4][2], const Unit& u, int wr, int wc, int fr, int fq) const {
        const int row0 = u.pm * BM + wr * 64 + fr, col0 = u.pn * BM + wc * 32 + 8 * fq;
#pragma unroll
        for (int ai = 0; ai < 2; ++ai)
#pragma unroll
            for (int m = 0; m < 4; ++m) {
                const int row = row0 + ai * HALF + m * 16;
#pragma unroll
                for (int bj = 0; bj < 2; ++bj) {
                    const u32x4 gw = *(const PG8_GAS u32x4*)(P + (size_t)row * ldp + goff + col0 + bj * HALF);
                    bf16_t* zp = Z + (size_t)row * 1024 + col0 + bj * HALF;
                    const f32x4 a0 = acc[ai][bj][m][0], a1 = acc[ai][bj][m][1];
                    float o[8];
                    o[0] = bf_lo(gw.x) * a0[0]; o[1] = bf_hi(gw.x) * a0[1]; o[2] = bf_lo(gw.y) * a0[2]; o[3] = bf_hi(gw.y) * a0[3];
                    o[4] = bf_lo(gw.z) * a1[0]; o[5] = bf_hi(gw.z) * a1[1]; o[6] = bf_lo(gw.w) * a1[2]; o[7] = bf_hi(gw.w) * a1[3];
                    if (!FIRST) {
                        const u32x4 zw = *(const PG8_GAS u32x4*)zp;
                        o[0] += bf_lo(zw.x); o[1] += bf_hi(zw.x); o[2] += bf_lo(zw.y); o[3] += bf_hi(zw.y);
                        o[4] += bf_lo(zw.z); o[5] += bf_hi(zw.z); o[6] += bf_lo(zw.w); o[7] += bf_hi(zw.w);
                    }
                    u32x4 w; w.x = cvt_pk_bf16(o[0], o[1]); w.y = cvt_pk_bf16(o[2], o[3]); w.z = cvt_pk_bf16(o[4], o[5]); w.w = cvt_pk_bf16(o[6], o[7]);
                    *(PG8_GAS u32x4*)zp = w;
                }
                if (m == 3) asm volatile("" ::: "memory");
            }
    }
};
template <class Epi, class Sched, bool ALIGN_EPI = false, bool SP2 = false>
__device__ __forceinline__ void gemm_phase(PG8_LAS unsigned char* lds, const Gemm g, const Sched& S, const Epi& E) {
    int tid_ = threadIdx.x; asm volatile("" : "+v"(tid_)); const int tid = tid_, wid = __builtin_amdgcn_readfirstlane(tid >> 6), lane = tid & 63, wr = wid >> 2, wc = wid & 3, fr = lane & 15, fq = lane >> 4;
    const int K = g.K, nt = K / BK;
    unsigned voffA[2], voffB[2];
#pragma unroll
    for (int i = 0; i < 2; ++i) { int R, C; stage_rc(tid * 16 + i * 8192, R, C); const int Rb = Epi::PERM ? ((R & ~31) + perm32(R & 31)) : R;
        voffA[i] = (unsigned)(R * K + C) * 2u; voffB[i] = (unsigned)(Rb * K + C) * 2u; }
    const size_t kstep = (size_t)(BK * 2);
    const size_t hstep = (size_t)HALF * K * 2;
    const size_t tstep = 2 * hstep;
    const unsigned ldsw = (unsigned)wid * 1024u;
    const int aoff = lds_byte(wr * 64 + fr, fq * 8), boff = lds_byte(wc * 32 + fr, fq * 8);
#define PG8_SA(b, h) (((b) * 2 + (h)) * HTB)
#define PG8_SB(b, h) ((4 + (b) * 2 + (h)) * HTB)
#define PG8_STAGE(bufoff, gbase, voff) do { _Pragma("unroll") for (int _i = 0; _i < 2; ++_i) \
        __builtin_amdgcn_global_load_lds((const unsigned*)((const char*)(gbase) + (voff)[_i]), (PG8_LAS unsigned*)(lds + (bufoff) + ldsw + _i * 8192), 16, 0, 0); } while (0)
#define PG8_LDA(dst, b, h) do { _Pragma("unroll") for (int m = 0; m < 4; ++m) _Pragma("unroll") for (int k = 0; k < 2; ++k) dst[m][k] = *(const PG8_LAS bf16x8*)(lds + PG8_SA(b, h) + aoff + m * 2048 + k * 1024); } while (0)
#define PG8_LDB(dst, b, h) do { _Pragma("unroll") for (int n = 0; n < 2; ++n) _Pragma("unroll") for (int k = 0; k < 2; ++k) dst[n][k] = *(const PG8_LAS bf16x8*)(lds + PG8_SB(b, h) + boff + n * 2048 + k * 1024); } while (0)
#define PG8_MMA(ai, bj, At, Bt) do { __builtin_amdgcn_s_setprio(1); _Pragma("unroll") for (int m = 0; m < 4; ++m) _Pragma("unroll") for (int n = 0; n < 2; ++n) _Pragma("unroll") for (int k = 0; k < 2; ++k) \
        acc[ai][bj][m][n] = __builtin_amdgcn_mfma_f32_16x16x32_bf16(Bt[n][k], At[m][k], acc[ai][bj][m][n], 0, 0, 0); __builtin_amdgcn_s_setprio(0); } while (0)
#define PG8_WAIT_V(n) asm volatile("s_waitcnt vmcnt(" #n ")" ::: "memory")
#define PG8_WAIT_L(n) asm volatile("s_waitcnt lgkmcnt(" #n ")" ::: "memory")
#define PG8_BAR __builtin_amdgcn_s_barrier()
#define PG8_SCHED __builtin_amdgcn_sched_barrier(0)
    Unit cur, nxt; int ui = 0;
    if (!S.next(0, cur)) return;
    f32x4 acc[2][2][4][2];
#pragma unroll
    for (int a = 0; a < 2; ++a)
#pragma unroll
        for (int b = 0; b < 2; ++b)
#pragma unroll
            for (int m = 0; m < 4; ++m)
#pragma unroll
                for (int n = 0; n < 2; ++n) acc[a][b][m][n] = (f32x4){0.f, 0.f, 0.f, 0.f};
    bf16x8 At[4][2], B0[2][2], B1[2][2];
    const char* cA = (const char*)g.A + (size_t)cur.pm * tstep + (size_t)(cur.pm >> 4) * g.a_gap; const char* cB = (const char*)g.Bt + (size_t)cur.pn * tstep;
    S.a_ready(cur);
    if constexpr (SP2) {
        PG8_STAGE(PG8_SB(0, 0), cB, voffB); PG8_STAGE(PG8_SB(0, 1), cB + hstep, voffB); PG8_STAGE(PG8_SA(0, 0), cA, voffA); PG8_STAGE(PG8_SA(0, 1), cA + hstep, voffA);
        if (wr == 1) PG8_BAR;
        PG8_WAIT_V(2); PG8_BAR;
        PG8_STAGE(PG8_SB(1, 0), cB + kstep, voffB); PG8_STAGE(PG8_SA(1, 0), cA + kstep, voffA); PG8_STAGE(PG8_SB(1, 1), cB + hstep + kstep, voffB);
        PG8_WAIT_V(6); PG8_BAR;
    } else {
        PG8_STAGE(PG8_SB(0, 0), cB, voffB); PG8_STAGE(PG8_SA(0, 0), cA, voffA); PG8_STAGE(PG8_SB(0, 1), cB + hstep, voffB); PG8_STAGE(PG8_SA(0, 1), cA + hstep, voffA);
        if (wr == 1) PG8_BAR;
        PG8_WAIT_V(4); PG8_BAR;
        PG8_STAGE(PG8_SB(1, 0), cB + kstep, voffB); PG8_STAGE(PG8_SA(1, 0), cA + kstep, voffA); PG8_STAGE(PG8_SB(1, 1), cB + hstep + kstep, voffB);
        PG8_WAIT_V(6); PG8_BAR;
    }
    for (;;) {
        const bool has_next = S.next(ui + 1, nxt);
        const char* nA = has_next ? (const char*)g.A + (size_t)nxt.pm * tstep + (size_t)(nxt.pm >> 4) * g.a_gap : cA; const char* nB = has_next ? (const char*)g.Bt + (size_t)nxt.pn * tstep : cB;
        for (int t = 0; t < nt; t += 2) {
            const bool last = (t == nt - 2);
            const char* a1 = cA + (size_t)(t + 1) * kstep;
            const char* a2 = last ? nA : cA + (size_t)(t + 2) * kstep; const char* b2 = last ? nB : cB + (size_t)(t + 2) * kstep;
            const char* a3 = a2 + kstep; const char* b3 = b2 + kstep;
            if (last && has_next) S.a_ready(nxt);
            if constexpr (SP2) {
            PG8_LDB(B0, 0, 0); PG8_LDB(B1, 0, 1); PG8_SCHED; PG8_LDA(At, 0, 0); PG8_STAGE(PG8_SA(1, 1), a1 + hstep, voffA);
            PG8_WAIT_V(8); PG8_WAIT_L(0); PG8_BAR; PG8_MMA(0, 0, At, B0); PG8_MMA(0, 1, At, B1); PG8_BAR; PG8_SCHED;
            PG8_LDA(At, 0, 1); PG8_STAGE(PG8_SB(0, 0), b2, voffB); PG8_STAGE(PG8_SB(0, 1), b2 + hstep, voffB); PG8_STAGE(PG8_SA(0, 0), a2, voffA);
            PG8_WAIT_V(8); PG8_WAIT_L(0); PG8_BAR; PG8_MMA(1, 0, At, B0); PG8_MMA(1, 1, At, B1); PG8_BAR; PG8_SCHED;
            PG8_LDB(B0, 1, 0); PG8_LDB(B1, 1, 1); PG8_SCHED; PG8_LDA(At, 1, 0); PG8_STAGE(PG8_SA(0, 1), a2 + hstep, voffA);
            PG8_WAIT_V(8); PG8_WAIT_L(0); PG8_BAR; PG8_MMA(0, 0, At, B0); PG8_MMA(0, 1, At, B1); PG8_BAR; PG8_SCHED;
            PG8_LDA(At, 1, 1); PG8_STAGE(PG8_SB(1, 0), b3, voffB); PG8_STAGE(PG8_SB(1, 1), b3 + hstep, voffB); PG8_STAGE(PG8_SA(1, 0), a3, voffA);
            PG8_WAIT_V(8); PG8_WAIT_L(0); PG8_BAR; PG8_MMA(1, 0, At, B0); PG8_MMA(1, 1, At, B1); PG8_BAR; PG8_SCHED;
            } else {
            PG8_LDB(B0, 0, 0); PG8_SCHED; PG8_LDA(At, 0, 0); PG8_STAGE(PG8_SA(1, 1), a1 + hstep, voffA);
            PG8_WAIT_L(8); PG8_BAR; PG8_WAIT_L(0); PG8_MMA(0, 0, At, B0); PG8_BAR; PG8_SCHED;
            PG8_LDB(B1, 0, 1); PG8_STAGE(PG8_SB(0, 0), b2, voffB);
            PG8_BAR; PG8_WAIT_L(0); PG8_MMA(0, 1, At, B1); PG8_BAR;
            PG8_LDA(At, 0, 1); PG8_STAGE(PG8_SA(0, 0), a2, voffA);
            PG8_BAR; PG8_WAIT_L(0); PG8_MMA(1, 0, At, B0); PG8_BAR; PG8_SCHED;
            PG8_STAGE(PG8_SB(0, 1), b2 + hstep, voffB);
            PG8_WAIT_V(6); PG8_BAR; PG8_MMA(1, 1, At, B1); PG8_BAR;
            PG8_LDB(B0, 1, 0); PG8_SCHED; PG8_LDA(At, 1, 0); PG8_STAGE(PG8_SA(0, 1), a2 + hstep, voffA);
            PG8_WAIT_L(8); PG8_BAR; PG8_WAIT_L(0); PG8_MMA(0, 0, At, B0); PG8_BAR; PG8_SCHED;
            PG8_LDB(B1, 1, 1); PG8_STAGE(PG8_SB(1, 0), b3, voffB);
            PG8_BAR; PG8_WAIT_L(0); PG8_MMA(0, 1, At, B1); PG8_BAR;
            PG8_LDA(At, 1, 1); PG8_STAGE(PG8_SA(1, 0), a3, voffA);
            PG8_BAR; PG8_WAIT_L(0); PG8_MMA(1, 0, At, B0); PG8_BAR; PG8_SCHED;
            PG8_STAGE(PG8_SB(1, 1), b3 + hstep, voffB);
            PG8_WAIT_V(6); PG8_BAR; PG8_MMA(1, 1, At, B1); PG8_BAR;
            }
        }
        if constexpr (ALIGN_EPI) { if (wr == 0) PG8_BAR; }
        if constexpr (!Epi::AFTER_DRAIN) { E(acc, cur, wr, wc, fr, fq); S.done(cur); }
        if (!has_next) break;
#pragma unroll
        for (int a = 0; a < 2; ++a)
#pragma unroll
            for (int b = 0; b < 2; ++b)
#pragma unroll
                for (int m = 0; m < 4; ++m)
#pragma unroll
                    for (int n = 0; n < 2; ++n) acc[a][b][m][n] = (f32x4){0.f, 0.f, 0.f, 0.f};
        cur = nxt; cA = nA; cB = nB; ++ui;
        if constexpr (ALIGN_EPI) { if (wr == 1) PG8_BAR; }
    }
    PG8_WAIT_V(0);
    if constexpr (!ALIGN_EPI) { if (wr == 0) PG8_BAR; }
    PG8_BAR;
    if constexpr (Epi::AFTER_DRAIN) { E.fused(acc, cur, wr, wc, fr, fq, lds, wid, lane); S.done(cur); }
#undef PG8_SA
#undef PG8_SB
#undef PG8_STAGE
#undef PG8_LDA
#undef PG8_LDB
#undef PG8_MMA
#undef PG8_WAIT_V
#undef PG8_WAIT_L
#undef PG8_BAR
#undef PG8_SCHED
}
}
#define GAS __attribute__((address_space(1)))
#define LAS __attribute__((address_space(3)))
typedef unsigned short bf16;
typedef unsigned u32x4 __attribute__((ext_vector_type(4)));
typedef unsigned u32x2 __attribute__((ext_vector_type(2)));
typedef float f32x4 __attribute__((ext_vector_type(4)));
typedef short bf16x8 __attribute__((ext_vector_type(8)));
constexpr int NWAVES = 8, NTHR = 512;
constexpr int BATCH = 4, SEQ = 8192, D = 1024, M = BATCH * SEQ, FF = 2816, NUP = 2 * FF, INW = 3328, DEPTH = 2;
constexpr int C_Q = 0, C_K = 512, C_V = 640, C_P = 768, C_GA = 1280, C_GB = 2304;
constexpr int LDS_BYTES = 147456;
constexpr size_t MiB = 1u << 20;
constexpr size_t WS_CTL = 0;
constexpr size_t WS_TAB = 1 * MiB;
constexpr size_t WS_BIAS = 1 * MiB + 512 * 1024;
constexpr size_t WS_SSQ = 2 * MiB;
constexpr size_t WS_W = 4 * MiB;
constexpr size_t W_UP = (size_t)NUP * D * 2, W_DN = (size_t)D * FF * 2, W_IN = (size_t)INW * D * 2, W_BR = (size_t)D * 512 * 2, W_OUT = (size_t)D * D * 2;
constexpr size_t LW_UP1 = 0, LW_DN1 = LW_UP1 + W_UP, LW_IN = LW_DN1 + W_DN, LW_BA = LW_IN + W_IN, LW_BP = LW_BA + W_BR, LW_OUT = LW_BP + W_BR, LW_UP2 = LW_OUT + W_OUT, LW_DN2 = LW_UP2 + W_UP, LW = LW_DN2 + W_DN;
static_assert(LW % 256 == 0 && WS_W + 2 * LW <= 100 * MiB, "weights");
constexpr size_t WS_HB = 100 * MiB;
constexpr size_t OUT_AO = 0, OUT_PL = 32 * MiB;
constexpr size_t WS_R1 = 164 * MiB;
constexpr size_t WS_Z = 372 * MiB;
constexpr size_t WS_END = 436 * MiB;
static_assert(WS_R1 + (size_t)M * INW * 2 <= WS_Z, "ws map");
constexpr size_t G_GAP = (size_t)4096 * (INW - FF) * 2;

__device__ __forceinline__ unsigned f2bf(float f) { unsigned u = __builtin_bit_cast(unsigned, f); return (u + 0x7fffu + ((u >> 16) & 1u)) >> 16; }
__device__ __forceinline__ unsigned pk2(float lo, float hi) { return f2bf(lo) | (f2bf(hi) << 16); }
__device__ __forceinline__ float bflo(unsigned w) { return __uint_as_float(w << 16); }
__device__ __forceinline__ float bfhi(unsigned w) { return __uint_as_float(w & 0xffff0000u); }
__device__ __forceinline__ void unpack8(const u32x4 w, float (&x)[8]) { x[0] = bflo(w.x); x[1] = bfhi(w.x); x[2] = bflo(w.y); x[3] = bfhi(w.y); x[4] = bflo(w.z); x[5] = bfhi(w.z); x[6] = bflo(w.w); x[7] = bfhi(w.w); }
__device__ __forceinline__ u32x4 pack8(const float (&x)[8]) { u32x4 w; w.x = pk2(x[0], x[1]); w.y = pk2(x[2], x[3]); w.z = pk2(x[4], x[5]); w.w = pk2(x[6], x[7]); return w; }
__device__ __forceinline__ float wave_sum(float v) {
#pragma unroll
    for (int o = 1; o < 64; o <<= 1) v += __shfl_xor(v, o);
    return v;
}
#define LDS_WAIT() asm volatile("s_waitcnt lgkmcnt(0)" ::: "memory")

__device__ __forceinline__ void transpose_item(const float* W, int K, int N, bf16* WT, const float* gk, int il, LAS float* scr, int item, int lane) {
    const int nblk = N / 32, kb = item / nblk, nb = item % nblk, k0 = 64 * kb, n0 = 32 * nb;
    const GAS float* Wg = (const GAS float*)W + (size_t)k0 * N + n0 + (lane & 31); const GAS float* gg = (const GAS float*)gk + k0;
    float v[32];
#pragma unroll
    for (int i = 0; i < 32; ++i) v[i] = Wg[(size_t)(2 * i + (lane >> 5)) * N];
    if (gk) {
#pragma unroll
        for (int i = 0; i < 32; ++i) v[i] *= gg[2 * i + (lane >> 5)];
    }
#pragma unroll
    for (int i = 0; i < 32; ++i) scr[(2 * i + (lane >> 5)) * 33 + (lane & 31)] = v[i];
    LDS_WAIT(); asm volatile("" ::: "memory");
    const int c = lane & 7;
#pragma unroll
    for (int j = 0; j < 4; ++j) { const int n = (lane >> 3) + 8 * j; const LAS float* s = scr + (8 * c) * 33 + n;
        u32x4 o; o.x = pk2(s[0 * 33], s[1 * 33]); o.y = pk2(s[2 * 33], s[3 * 33]); o.z = pk2(s[4 * 33], s[5 * 33]); o.w = pk2(s[6 * 33], s[7 * 33]);
        const int nn = n0 + n, drow = il < 0 ? nn : 256 * (nn >> 7) + (nn & 127) + il;
        *(GAS u32x4*)(WT + (size_t)drow * K + k0 + 8 * c) = o; }
    LDS_WAIT(); asm volatile("" ::: "memory");
}
struct Args { const float* in[19]; float* out; unsigned char* ws; int lo, hi; };
__device__ __forceinline__ void prep_phase(const Args& P, LAS unsigned char* lds, int gw, int NGW, int lane, int gtid, int NT, int parts) {
    LAS float* scr = (LAS float*)(lds + (threadIdx.x >> 6) * 16384);
    constexpr int I_UP = (D / 64) * (FF / 32), I_DN = (FF / 64) * (D / 32), I_IN = (D / 64) * (INW / 32), I_BA = (512 / 64) * (D / 32), I_OUT = (D / 64) * (D / 32);
    constexpr int I_LAYER = 4 * I_UP + 2 * I_DN + I_IN + I_BA + I_OUT;
    if (parts & 1) for (int it = gw; it < DEPTH * I_LAYER; it += NGW) {
        const int l = it / I_LAYER; int r = it % I_LAYER;
        unsigned char* wl = P.ws + WS_W + (size_t)l * LW;
        if (r < I_UP) { transpose_item(P.in[2] + (size_t)l * D * FF, D, FF, (bf16*)(wl + LW_UP1), P.in[1] + l * D, 0, scr, r, lane); continue; } r -= I_UP;
        if (r < I_UP) { transpose_item(P.in[3] + (size_t)l * D * FF, D, FF, (bf16*)(wl + LW_UP1), P.in[1] + l * D, 128, scr, r, lane); continue; } r -= I_UP;
        if (r < I_DN) { transpose_item(P.in[4] + (size_t)l * FF * D, FF, D, (bf16*)(wl + LW_DN1), nullptr, -1, scr, r, lane); continue; } r -= I_DN;
        if (r < I_IN) { transpose_item(P.in[6] + (size_t)l * D * INW, D, INW, (bf16*)(wl + LW_IN), P.in[5] + l * D, -1, scr, r, lane); continue; } r -= I_IN;
        if (r < I_BA) { transpose_item(P.in[11] + (size_t)l * 512 * D, 512, D, (bf16*)(wl + LW_BA), nullptr, -1, scr, r, lane); continue; } r -= I_BA;
        if (r < I_OUT) { transpose_item(P.in[13] + (size_t)l * D * D, D, D, (bf16*)(wl + LW_OUT), nullptr, -1, scr, r, lane); continue; } r -= I_OUT;
        if (r < I_UP) { transpose_item(P.in[15] + (size_t)l * D * FF, D, FF, (bf16*)(wl + LW_UP2), P.in[14] + l * D, 0, scr, r, lane); continue; } r -= I_UP;
        if (r < I_UP) { transpose_item(P.in[16] + (size_t)l * D * FF, D, FF, (bf16*)(wl + LW_UP2), P.in[14] + l * D, 128, scr, r, lane); continue; } r -= I_UP;
        transpose_item(P.in[17] + (size_t)l * FF * D, FF, D, (bf16*)(wl + LW_DN2), nullptr, -1, scr, r, lane);
    }
    if (parts & 2) for (int it = gw; it < DEPTH * 64 * 16; it += NGW) {
        const int l = __builtin_amdgcn_readfirstlane(it >> 10), co = __builtin_amdgcn_readfirstlane((it >> 4) & 63), n = (it & 15) * 64 + lane, c0 = co * 8, g = c0 >> 7;
        const GAS float* pw = (const GAS float*)P.in[9] + ((size_t)l * 512 + c0) * 128 + 2 * lane;
        const GAS float* sc = (const GAS float*)P.in[10] + l * 512 + g * 128 + 2 * lane;
        const GAS float* wb = (const GAS float*)P.in[12] + ((size_t)l * 512 + g * 128) * D + n;
        const float s0 = sc[0], s1 = sc[1];
        float pws[8][2];
#pragma unroll
        for (int j = 0; j < 8; ++j) { pws[j][0] = pw[j * 128] * s0; pws[j][1] = pw[j * 128 + 1] * s1; }
        float acc[8];
#pragma unroll
        for (int j = 0; j < 8; ++j) acc[j] = 0.f;
#pragma unroll
        for (int d = 0; d < 128; ++d) {
            const float w = wb[(size_t)d * D];
#pragma unroll
            for (int j = 0; j < 8; ++j) acc[j] += __uint_as_float(__builtin_amdgcn_readlane(__float_as_uint(pws[j][d & 1]), d >> 1)) * w;
        }
        *(GAS u32x4*)((bf16*)(P.ws + WS_W + (size_t)l * LW + LW_BP) + (size_t)n * 512 + c0) = pack8(acc);
    }
    if (parts & 4) for (int idx = gtid; idx < DEPTH * INW; idx += NT) { const int l = idx / INW, c = idx % INW; ((float*)(P.ws + WS_BIAS))[idx] = c >= C_GA ? P.in[7][l * 2 * D + c - C_GA] : 0.f; }
    if (parts & 4) for (int idx = gtid; idx < SEQ * 8; idx += NT) {
        const int pos = idx >> 3, i = idx & 7;
        const float pf = (float)pow(500000.0, (double)(2 * i) / 16.0);
        const float inv = 1.0f / pf;
        const float ang = (float)pos * inv;
        const double x = (double)ang;
        const double kd = rint(x * 0.63661977236758134308);
        const double r = fma(-kd, 6.123233995736766035868820147292e-17, fma(-kd, 1.5707963267948965580, x));
        const double r2 = r * r;
        double sp = 1.0 / 6227020800.0; sp = sp * r2 * -1.0 + 1.0 / 39916800.0; sp = -sp * r2 + 1.0 / 362880.0; sp = -sp * r2 + 1.0 / 5040.0; sp = -sp * r2 + 1.0 / 120.0; sp = -sp * r2 + 1.0 / 6.0; sp = -sp * r2 + 1.0;
        const double sr = sp * r;
        double cp = 1.0 / 479001600.0; cp = -cp * r2 + 1.0 / 3628800.0; cp = -cp * r2 + 1.0 / 40320.0; cp = -cp * r2 + 1.0 / 720.0; cp = -cp * r2 + 1.0 / 24.0; cp = -cp * r2 + 0.5; cp = -cp * r2 + 1.0;
        const int q = ((int)kd) & 3;
        const double cs = (q == 0) ? cp : (q == 1) ? -sr : (q == 2) ? -cp : sr;
        const double sn = (q == 0) ? sr : (q == 1) ? cp : (q == 2) ? -sr : -cp;
        float* tab = (float*)(P.ws + WS_TAB);
        tab[pos * 16 + i] = (float)cs; tab[pos * 16 + 8 + i] = (float)sn;
    }
    if (parts & 8) for (int m = gw; m < M; m += 2 * NGW) {
        f32x4 v[2][4]; float s[2];
#pragma unroll
        for (int r = 0; r < 2; ++r) { const GAS f32x4* xr = (const GAS f32x4*)(P.in[0] + (size_t)(m + r * NGW) * D) + lane;
#pragma unroll
            for (int j = 0; j < 4; ++j) v[r][j] = xr[64 * j]; }
#pragma unroll
        for (int r = 0; r < 2; ++r) { float q = 0.f;
#pragma unroll
            for (int j = 0; j < 4; ++j) q += (v[r][j][0] * v[r][j][0] + v[r][j][1] * v[r][j][1]) + (v[r][j][2] * v[r][j][2] + v[r][j][3] * v[r][j][3]);
            s[r] = wave_sum(q); }
#pragma unroll
        for (int r = 0; r < 2; ++r) { const int mm = m + r * NGW; GAS u32x2* o8 = (GAS u32x2*)(P.ws + WS_HB + (size_t)mm * D * 2) + lane;
#pragma unroll
            for (int j = 0; j < 4; ++j) { u32x2 w; w.x = pk2(v[r][j][0], v[r][j][1]); w.y = pk2(v[r][j][2], v[r][j][3]); o8[64 * j] = w; }
            if (lane < 16) ((GAS float*)(P.ws + WS_SSQ))[(size_t)mm * 16 + lane] = lane == 0 ? s[r] : 0.f; }
    }
}

constexpr int KP = 144, VP = 784, OFF_V = 384 * KP;
static_assert(OFF_V + 64 * VP <= 131072, "attention LDS");
__device__ __forceinline__ bf16x8 as_bf16x8(u32x4 w) { return __builtin_bit_cast(bf16x8, w); }
__device__ __forceinline__ u32x4 pack_p(const f32x4 a, const f32x4 b) {
    u32x4 p;
    asm volatile("v_cvt_pk_bf16_f32 %0, %4, %5\n\tv_cvt_pk_bf16_f32 %1, %6, %7\n\tv_cvt_pk_bf16_f32 %2, %8, %9\n\tv_cvt_pk_bf16_f32 %3, %10, %11\n\ts_nop 1"
                 : "=&v"(p.x), "=&v"(p.y), "=&v"(p.z), "=&v"(p.w)
                 : "v"(a[0]), "v"(a[1]), "v"(a[2]), "v"(a[3]), "v"(b[0]), "v"(b[1]), "v"(b[2]), "v"(b[3]));
    return p;
}
__device__ __forceinline__ void attn_phase(LAS unsigned char* lds, const bf16* PROJ, bf16* AO, const float* tab, const float* sink, int G, int c0, bool own) {
    int tid_ = threadIdx.x; asm volatile("" : "+v"(tid_));
    const int tid = tid_, wid = __builtin_amdgcn_readfirstlane(tid >> 6), lane = tid & 63, fr = lane & 15, fq = lane >> 4;
    const float SC = 0.125f * 1.4426950408889634f, L2E = 1.4426950408889634f;
    const int u_first = own ? ((((c0 & 7) * 32 + (c0 >> 3)) << 1)) : c0, u_step = own ? 1 : G, u_end = own ? u_first + 2 : BATCH * 64 * 2;
    for (int u = u_first; u < u_end; u += u_step) {
        const int kvh = u & 1, blk = (u >> 1) & 63, b = u >> 7;
        const int h = kvh * 4 + (wid >> 1);
        const bf16* qbase = PROJ + ((size_t)b * SEQ + blk * 128 + (wid & 1) * 64 + fr) * INW + C_Q + h * 64 + 8 * fq;
        u32x4 qn0 = *(const GAS u32x4*)qbase, qn1 = *(const GAS u32x4*)(qbase + 32);
        __syncthreads();
#pragma unroll
        for (int it = 0; it < 6; ++it) {
            const int p = it * NTHR + tid, row = p >> 3, pc = p & 7;
            const int kpos = blk * 128 - 128 + row;
            const bool ok = (kpos >= 0) && (kpos < SEQ);
            const int kp = ok ? kpos : 0;
            const bf16* src = PROJ + (size_t)(b * SEQ + kp) * INW + C_K + kvh * 64 + pc * 8;
            u32x4 kw = *(const GAS u32x4*)src;
            if (!ok) kw = (u32x4){0u, 0u, 0u, 0u};
            float x[8], y[8]; unpack8(kw, x);
#pragma unroll
            for (int j = 0; j < 8; ++j) y[j] = __shfl_xor(x[j], 1);
            if (pc < 2) {
                const GAS f32x4* tp = (const GAS f32x4*)(tab + kp * 16);
                const f32x4 ca = tp[0], cb = tp[1], sa = tp[2], sb = tp[3];
                const float sg = pc == 0 ? -1.f : 1.f;
#pragma unroll
                for (int j = 0; j < 4; ++j) { x[j] = x[j] * ca[j] + sg * y[j] * sa[j]; x[4 + j] = x[4 + j] * cb[j] + sg * y[4 + j] * sb[j]; }
                kw = pack8(x);
            }
            *(LAS u32x4*)(lds + row * KP + pc * 16) = kw;
        }
#pragma unroll
        for (int it = 0; it < 6; ++it) {
            const int p = it * NTHR + tid, pc = p / 384, row = p - pc * 384;
            const int kpos = blk * 128 - 128 + row;
            const bool ok = (kpos >= 0) && (kpos < SEQ);
            const int kp = ok ? kpos : 0;
            u32x4 vw = *(const GAS u32x4*)(PROJ + (size_t)(b * SEQ + kp) * INW + C_V + kvh * 64 + pc * 8);
            if (!ok) vw = (u32x4){0u, 0u, 0u, 0u};
            LAS unsigned short* vt = (LAS unsigned short*)(lds + OFF_V) + (pc * 8) * (VP / 2) + row;
            vt[0 * (VP / 2)] = (unsigned short)(vw.x & 0xffffu); vt[1 * (VP / 2)] = (unsigned short)(vw.x >> 16);
            vt[2 * (VP / 2)] = (unsigned short)(vw.y & 0xffffu); vt[3 * (VP / 2)] = (unsigned short)(vw.y >> 16);
            vt[4 * (VP / 2)] = (unsigned short)(vw.z & 0xffffu); vt[5 * (VP / 2)] = (unsigned short)(vw.z >> 16);
            vt[6 * (VP / 2)] = (unsigned short)(vw.w & 0xffffu); vt[7 * (VP / 2)] = (unsigned short)(vw.w >> 16);
        }
        __syncthreads();
        const float sink2 = sink[h] * L2E;
        const bool edge = (blk == 0) || (blk == 63);
#pragma unroll 1
        for (int i = 0; i < 4; ++i) {
            const int r0 = ((wid & 1) * 4 + i) * 16, r = r0 + fr, pos = blk * 128 + r;
            const size_t mq = (size_t)b * SEQ + pos;
            u32x4 q0 = qn0; const u32x4 q1 = qn1;
            { const bf16* qp = qbase + (size_t)(i < 3 ? i + 1 : i) * 16 * INW; qn0 = *(const GAS u32x4*)qp; qn1 = *(const GAS u32x4*)(qp + 32); }
            {
                float x[8], y[8]; unpack8(q0, x);
#pragma unroll
                for (int j = 0; j < 8; ++j) y[j] = __shfl_xor(x[j], 16);
                if (fq < 2) {
                    const GAS f32x4* tp = (const GAS f32x4*)(tab + pos * 16);
                    const f32x4 ca = tp[0], cb = tp[1], sa = tp[2], sb = tp[3];
                    const float sg = fq == 0 ? -1.f : 1.f;
#pragma unroll
                    for (int j = 0; j < 4; ++j) { x[j] = x[j] * ca[j] + sg * y[j] * sa[j]; x[4 + j] = x[4 + j] * cb[j] + sg * y[4 + j] * sb[j]; }
                    q0 = pack8(x);
                }
            }
            const bf16x8 Q0 = as_bf16x8(q0), Q1 = as_bf16x8(q1);
            const int kst = r0 < 96 ? r0 : 96;
            f32x4 sA[9], sB[9];
            const LAS unsigned char* kbp = lds + (kst + 8 * (fr >> 2) + (fr & 3)) * KP + fq * 16;
#pragma unroll
            for (int c = 0; c < 9; ++c) {
                const LAS unsigned char* ka = kbp + c * 32 * KP;
                const bf16x8 a0 = *(const LAS bf16x8*)ka, a1 = *(const LAS bf16x8*)(ka + 64);
                const bf16x8 b0 = *(const LAS bf16x8*)(ka + 4 * KP), b1 = *(const LAS bf16x8*)(ka + 4 * KP + 64);
                f32x4 z = (f32x4){0.f, 0.f, 0.f, 0.f};
                sA[c] = __builtin_amdgcn_mfma_f32_16x16x32_bf16(a0, Q0, z, 0, 0, 0); sA[c] = __builtin_amdgcn_mfma_f32_16x16x32_bf16(a1, Q1, sA[c], 0, 0, 0);
                sB[c] = __builtin_amdgcn_mfma_f32_16x16x32_bf16(b0, Q0, z, 0, 0, 0); sB[c] = __builtin_amdgcn_mfma_f32_16x16x32_bf16(b1, Q1, sB[c], 0, 0, 0);
            }
            float mx = sink2;
            const int klo = r, khi = r + 256, kmin = 128 - blk * 128, kmax = SEQ + 128 - blk * 128;
#pragma unroll
            for (int c = 0; c < 9; ++c) {
                if (c == 0 || c == 8 || edge) {
#pragma unroll
                    for (int jj = 0; jj < 4; ++jj) {
                        const int ka = kst + 32 * c + 8 * fq + jj, kb = ka + 4;
                        const bool va = (ka >= klo) && (ka <= khi) && (ka >= kmin) && (ka < kmax), vb = (kb >= klo) && (kb <= khi) && (kb >= kmin) && (kb < kmax);
                        sA[c][jj] = va ? sA[c][jj] * SC : -1e30f; sB[c][jj] = vb ? sB[c][jj] * SC : -1e30f;
                        mx = fmaxf(mx, fmaxf(sA[c][jj], sB[c][jj]));
                    }
                } else {
#pragma unroll
                    for (int jj = 0; jj < 4; ++jj) { sA[c][jj] *= SC; sB[c][jj] *= SC; mx = fmaxf(mx, fmaxf(sA[c][jj], sB[c][jj])); }
                }
            }
            mx = fmaxf(mx, __shfl_xor(mx, 16)); mx = fmaxf(mx, __shfl_xor(mx, 32));
            float sum = 0.f;
#pragma unroll
            for (int c = 0; c < 9; ++c)
#pragma unroll
                for (int jj = 0; jj < 4; ++jj) { sA[c][jj] = __builtin_amdgcn_exp2f(sA[c][jj] - mx); sB[c][jj] = __builtin_amdgcn_exp2f(sB[c][jj] - mx); sum += sA[c][jj] + sB[c][jj]; }
            sum += __shfl_xor(sum, 16); sum += __shfl_xor(sum, 32);
            const float inv = 1.0f / (sum + __builtin_amdgcn_exp2f(sink2 - mx));
            f32x4 o[4];
#pragma unroll
            for (int dt = 0; dt < 4; ++dt) o[dt] = (f32x4){0.f, 0.f, 0.f, 0.f};
            const LAS unsigned char* vbp = lds + OFF_V + fr * VP + (kst + 8 * fq) * 2;
#pragma unroll
            for (int c = 0; c < 9; ++c) {
                const bf16x8 pf = as_bf16x8(pack_p(sA[c], sB[c]));
#pragma unroll
                for (int dt = 0; dt < 4; ++dt) {
                    const bf16x8 vf = *(const LAS bf16x8*)(vbp + dt * 16 * VP + c * 64);
                    o[dt] = __builtin_amdgcn_mfma_f32_16x16x32_bf16(vf, pf, o[dt], 0, 0, 0);
                }
            }
            bf16* op = AO + mq * 512 + h * 64 + 4 * fq;
#pragma unroll
            for (int dt = 0; dt < 4; ++dt) { const f32x4 ov = o[dt] * inv; u32x2 w; w.x = pk2(ov[0], ov[1]); w.y = pk2(ov[2], ov[3]); *(GAS u32x2*)(op + 16 * dt) = w; }
        }
    }
    __syncthreads();
}
__device__ __forceinline__ void pool_run(const bf16* PROJ, bf16* PL, int m0, int T, int lane) {
    const int h = 1 << (lane >> 4), t0 = m0 & (SEQ - 1);
    const bf16* base = PROJ + (size_t)(m0 - t0) * INW + C_P + lane * 8;
    bf16* outp = PL + (size_t)m0 * 512 + lane * 8;
    float s[8];
#pragma unroll
    for (int k = 0; k < 8; ++k) s[k] = 0.f;
#pragma unroll
    for (int j = 0; j < 16; ++j) {
        const int r = t0 - h + j; const bool ok = (j < 2 * h) && (r >= 0) && (r < SEQ);
        u32x4 w = *(const GAS u32x4*)(base + (size_t)(ok ? r : t0) * INW);
        if (!ok) w = (u32x4){0u, 0u, 0u, 0u};
        float x[8]; unpack8(w, x);
#pragma unroll
        for (int k = 0; k < 8; ++k) s[k] += x[k];
    }
    for (int i0 = 0; i0 < T; i0 += 4) {
        u32x4 ws[4], wa[4], wr[4];
#pragma unroll
        for (int i = 0; i < 4; ++i) {
            const int t = t0 + i0 + i, ra = t + h, rr = t - h;
            ws[i] = *(const GAS u32x4*)(base + (size_t)t * INW);
            wa[i] = *(const GAS u32x4*)(base + (size_t)(ra < SEQ ? ra : t) * INW); if (ra >= SEQ) wa[i] = (u32x4){0u, 0u, 0u, 0u};
            wr[i] = *(const GAS u32x4*)(base + (size_t)(rr >= 0 ? rr : t) * INW); if (rr < 0) wr[i] = (u32x4){0u, 0u, 0u, 0u};
        }
#pragma unroll
        for (int i = 0; i < 4; ++i) {
            const int t = t0 + i0 + i;
            const int lo = (t - h) > 0 ? (t - h) : 0, hi = (t + h) < SEQ ? (t + h) : SEQ;
            const float ic = 1.0f / (float)(hi - lo);
            float x[8], o[8]; unpack8(ws[i], x);
#pragma unroll
            for (int k = 0; k < 8; ++k) o[k] = s[k] * ic - x[k];
            *(GAS u32x4*)(outp + (size_t)(i0 + i) * 512) = pack8(o);
            float xa[8], xr[8]; unpack8(wa[i], xa); unpack8(wr[i], xr);
#pragma unroll
            for (int k = 0; k < 8; ++k) s[k] += xa[k] - xr[k];
        }
    }
}
__device__ __forceinline__ void final_phase(float* out, const bf16* hb, const float* ssq, const float* gfin, int gw, int NGW, int lane, int m_end) {
    const GAS f32x4* gr = (const GAS f32x4*)gfin + 2 * lane;
    const f32x4 g0 = gr[0], g1 = gr[1], g2 = gr[128], g3 = gr[129];
    for (int m = gw; m < m_end; m += 2 * NGW) {
        f32x4 p[2]; u32x4 hv[2][2];
#pragma unroll
        for (int r = 0; r < 2; ++r) { const int mm = m + r * NGW;
            const GAS f32x4* sp = (const GAS f32x4*)(ssq + (size_t)mm * 16) + (lane & 3);
            p[r] = sp[0];
            const GAS u32x4* hr = (const GAS u32x4*)(hb + (size_t)mm * D) + lane; hv[r][0] = hr[0]; hv[r][1] = hr[64]; }
#pragma unroll
        for (int r = 0; r < 2; ++r) { const int mm = m + r * NGW;
            float q = (p[r][0] + p[r][1]) + (p[r][2] + p[r][3]); q += __shfl_xor(q, 1); q += __shfl_xor(q, 2);
            const float rs = rsqrtf(q * (1.0f / D) + 1e-6f);
            GAS f32x4* xr = (GAS f32x4*)(out + (size_t)mm * D) + 2 * lane;
            float x[8]; unpack8(hv[r][0], x);
            xr[0] = (f32x4){x[0], x[1], x[2], x[3]} * rs * g0; xr[1] = (f32x4){x[4], x[5], x[6], x[7]} * rs * g1;
            unpack8(hv[r][1], x);
            xr[128] = (f32x4){x[0], x[1], x[2], x[3]} * rs * g2; xr[129] = (f32x4){x[4], x[5], x[6], x[7]} * rs * g3; }
    }
}

#define RLX_AGENT __ATOMIC_RELAXED, __HIP_MEMORY_SCOPE_AGENT
#define XB_TMO      128
#define XB_XCNT(j)  (256  + 64 * (j))
#define XB_XSUB(j)  (1280 + 64 * (j))
#define XB_XGEN(j)  (2304 + 64 * (j))
#define XB_TOP      3328
#define XB_TOPGEN   3392
#define XCD_BAR_WORDS 3456
#define XB_SPIN_CAP (1u << 18)

__device__ __forceinline__ unsigned xb_ld(unsigned* p)              { return __hip_atomic_load(p, __ATOMIC_RELAXED, __HIP_MEMORY_SCOPE_AGENT); }
__device__ __forceinline__ unsigned xb_add(unsigned* p, unsigned v) { return __hip_atomic_fetch_add(p, v, __ATOMIC_RELAXED, __HIP_MEMORY_SCOPE_AGENT); }
__device__ __forceinline__ unsigned xb_xcc_id() { return (unsigned)__builtin_amdgcn_s_getreg((3 << 11) | 20) & 0xFu; }
#define XB_SPIN(cond, bar) do { unsigned _sp = 0; while (cond) { __builtin_amdgcn_s_sleep(1); \
    if ((++_sp & 255u) == 0u) { if (xb_ld(&(bar)[XB_TMO])) break; if (_sp > XB_SPIN_CAP) { atomicAdd(&(bar)[XB_TMO], 1u); break; } } } } while (0)

struct XcdBarrier {
    unsigned* bar; unsigned x;
    volatile LAS unsigned* st;
};

__device__ __forceinline__ XcdBarrier xcd_barrier_post(unsigned* bar, volatile LAS unsigned* st) {
    XcdBarrier b; b.bar = bar; b.x = xb_xcc_id(); b.st = st;
    if (threadIdx.x == 0) (void)xb_add(&bar[XB_XCNT(b.x)], 1u);
    return b;
}
__device__ __forceinline__ void xcd_barrier_complete(unsigned* bar, unsigned x, unsigned& nloc, unsigned& nx) {
    const unsigned G = gridDim.x * gridDim.y * gridDim.z;
    unsigned sum, cnt, mine, sp = 0u;
    for (;;) {
        sum = 0u; cnt = 0u; mine = 0u;
#pragma unroll
        for (unsigned j = 0; j < 16; ++j) { const unsigned c = xb_ld(&bar[XB_XCNT(j)]); sum += c; cnt += (c > 0u) ? 1u : 0u; mine = (j == x) ? c : mine; }
        if (sum == G) break;
        __builtin_amdgcn_s_sleep(1);
        if ((++sp & 255u) == 0u) { if (xb_ld(&bar[XB_TMO])) break; if (sp > XB_SPIN_CAP) { atomicAdd(&bar[XB_TMO], 1u); break; } }
    }
    nloc = mine > 0u ? mine : 1u; nx = cnt > 0u ? cnt : 1u;
}

__device__ __forceinline__ void xcd_barrier(const XcdBarrier& b) {
    asm volatile("s_waitcnt vmcnt(0)" ::: "memory");
    __syncthreads();
    if (threadIdx.x == 0) {
        unsigned* bar = b.bar;
        __builtin_amdgcn_s_waitcnt(0);
        unsigned nloc = b.st[0], nx = b.st[1];
        if (nloc == 0u) { xcd_barrier_complete(bar, b.x, nloc, nx); b.st[0] = nloc; b.st[1] = nx; }
        const unsigned old = xb_add(&bar[XB_XSUB(b.x)], 1u);
        const unsigned gen = old / nloc;
        if (old + 1u == (gen + 1u) * nloc) {
            __builtin_amdgcn_fence(__ATOMIC_RELEASE, "agent");
            asm volatile("s_waitcnt vmcnt(0)" ::: "memory");
            const unsigned og = xb_add(&bar[XB_TOP], 1u);
            const unsigned tg = og / nx;
            if (og + 1u == (tg + 1u) * nx) xb_add(&bar[XB_TOPGEN], 1u);
            else XB_SPIN(xb_ld(&bar[XB_TOPGEN]) == tg, bar);
            __builtin_amdgcn_fence(__ATOMIC_ACQUIRE, "agent");
            xb_add(&bar[XB_XGEN(b.x)], 1u);
            asm volatile("s_waitcnt vmcnt(0)" ::: "memory");
        } else {
            XB_SPIN(xb_ld(&bar[XB_XGEN(b.x)]) == gen, bar);
            __builtin_amdgcn_fence(__ATOMIC_ACQUIRE, "agent");
            asm volatile("s_waitcnt vmcnt(0)" ::: "memory");
        }
    }
    __syncthreads();
}

#define XB_LSUB(j)  (3456 + 64 * (j))
#define XB_LGEN(j)  (4480 + 64 * (j))
#define XB_TAB      5504
__device__ __forceinline__ void xcd_local_barrier(const XcdBarrier& b) {
    asm volatile("s_waitcnt vmcnt(0)" ::: "memory");
    __syncthreads();
    if (threadIdx.x == 0) {
        unsigned* bar = b.bar;
        __builtin_amdgcn_s_waitcnt(0);
        const unsigned nloc = b.st[0];
        const unsigned old = xb_add(&bar[XB_LSUB(b.x)], 1u);
        const unsigned gen = old / nloc;
        if (old + 1u == (gen + 1u) * nloc) xb_add(&bar[XB_LGEN(b.x)], 1u);
        else XB_SPIN(xb_ld(&bar[XB_LGEN(b.x)]) == gen, bar);
        __builtin_amdgcn_fence(__ATOMIC_ACQUIRE, "agent");
        asm volatile("s_waitcnt vmcnt(0)" ::: "memory");
    }
    __syncthreads();
}
constexpr int RS_OFF = 131072 + 1024, GB_OFF = RS_OFF + 4096;
static_assert(GB_OFF + 8192 <= LDS_BYTES, "spare LDS");
template <class Sched> __device__ __forceinline__ void rstd_setup(LAS unsigned char* lds, const float* ssq, const Sched& S) {
    LAS float* tab = (LAS float*)(lds + RS_OFF);
    int tid = threadIdx.x; asm volatile("" : "+v"(tid));
    int prev = -1; pg8::Unit u;
    for (int i = 0; S.next(i, u); ++i) {
        if (u.pm == prev) continue;
        prev = u.pm;
        const GAS f32x4* sp = (const GAS f32x4*)(ssq + (size_t)(u.pm * 256 + (tid >> 1)) * 16) + (tid & 1) * 2;
        const f32x4 p = sp[0] + sp[1];
        float q = (p[0] + p[1]) + (p[2] + p[3]); q += __shfl_xor(q, 1);
        if (!(tid & 1)) tab[((u.pm >> 3) & 3) * 256 + (tid >> 1)] = rsqrtf(q * (1.0f / D) + 1e-6f);
    }
    __syncthreads();
}

#ifndef MK_N_LAUNCHES
#define MK_N_LAUNCHES 1
#endif
#ifndef REP_PREP
#define REP_PREP 1
#endif
#ifndef REP_PREP_PARTS
#define REP_PREP_PARTS 15
#endif
#ifndef REP_UP
#define REP_UP 1
#endif
#ifndef REP_IN
#define REP_IN 1
#endif
#ifndef REP_ATT
#define REP_ATT 1
#endif
#ifndef REP_DOWN
#define REP_DOWN 1
#endif
#ifndef REP_OUT
#define REP_OUT 1
#endif
#ifndef REP_UPNULL
#define REP_UPNULL 0
#endif
#ifndef REP_BR
#define REP_BR 1
#endif
constexpr int NPH = 2 + 8 * DEPTH;
__global__ void __launch_bounds__(NTHR, 2) mk_fwd(Args a) {
    extern __shared__ __attribute__((aligned(16))) unsigned char lds_raw[];
    LAS unsigned char* lds = (LAS unsigned char*)lds_raw;
    cg::grid_group grid = cg::this_grid();
    const int tid = threadIdx.x, lane = tid & 63, wave = __builtin_amdgcn_readfirstlane(tid >> 6);
    const int G = gridDim.x, bx = blockIdx.x;
    const int gw = bx * NWAVES + wave, NGW = G * NWAVES, gtid = bx * NTHR + tid, NT = G * NTHR;
    unsigned char* ws = a.ws;
    volatile LAS unsigned* MISC = (volatile LAS unsigned*)(lds + 131072 + 320);
    if (tid < 32) MISC[tid] = 0u;
    __syncthreads();
    XcdBarrier bar = xcd_barrier_post((unsigned*)(ws + WS_CTL) + 1024, MISC + 8);
    if (tid == 0) __hip_atomic_store(&bar.bar[XB_TAB + bx], bar.x + 1u, __ATOMIC_RELAXED, __HIP_MEMORY_SCOPE_AGENT);
    if (a.lo < 0) grid.sync();
    int ph = 0;
#define PH_ON (ph >= a.lo && ph < a.hi)
#define PH_END do { if (PH_ON && ph + 1 < a.hi) xcd_barrier(bar); ++ph; } while (0)

    if (PH_ON) for (int rep = 0; rep < REP_PREP; ++rep) { if (rep) xcd_barrier(bar); prep_phase(a, lds, gw, NGW, lane, gtid, NT, rep ? REP_PREP_PARTS : 15); }
    PH_END;
    bool local_ok;
    {
        if (tid == 0) MISC[16] = 1u;
        __syncthreads();
        bool okc = true;
        if (tid < G && tid < NTHR) { const unsigned v = xb_ld(&bar.bar[XB_TAB + tid]), w = xb_ld(&bar.bar[XB_TAB + (tid & 7)]); okc = (v == w) && (v != 0u);
            if (tid < 8) { for (int u2 = 0; u2 < 8; ++u2) if (u2 != tid && xb_ld(&bar.bar[XB_TAB + u2]) == v) okc = false; } }
        if (!okc) MISC[16] = 0u;
        __syncthreads();
        local_ok = (MISC[16] != 0u) && (G == 256) && (MISC[8] == 32u) && (a.hi - a.lo == NPH);
    }
#define PH_END_L(loc) do { if (PH_ON && ph + 1 < a.hi) { if (local_ok && (loc)) xcd_local_barrier(bar); else xcd_barrier(bar); } ++ph; } while (0)
#pragma unroll 1
    for (int l = 0; l < DEPTH; ++l) {
        unsigned char* wsl = a.ws; asm volatile("" : "+s"(wsl));
        unsigned char* wl = wsl + WS_W + (size_t)l * LW;
        float* ssq = (float*)(wsl + WS_SSQ);
        bf16* HB = (bf16*)(wsl + WS_HB); bf16* AO = (bf16*)((unsigned char*)a.out + OUT_AO); bf16* PL = (bf16*)((unsigned char*)a.out + OUT_PL);
        bf16* R1 = (bf16*)(wsl + WS_R1); bf16* Z = (bf16*)(wsl + WS_Z);
        const float* tab = (const float*)(wsl + WS_TAB);
#pragma unroll 1
        for (int f = 0; f < 2; ++f) {
            if (PH_ON) for (int rep = 0; rep < REP_UP; ++rep) {   if (rep) xcd_barrier(bar);
                pg8::Gemm g{HB, (const bf16*)(wl + (f ? LW_UP2 : LW_UP1)), M, NUP, D}; pg8::StaticOrder S; S.init(M, NUP, G, bx);
                rstd_setup(lds, ssq, S);
                pg8::EpiUp E{R1, (const LAS float*)(lds + RS_OFF), FF, G_GAP / 2};
                pg8::gemm_phase<pg8::EpiUp, pg8::StaticOrder, true, true>(lds, g, S, E);
            }
            if (PH_ON) for (int rep = 0; rep < REP_UPNULL; ++rep) {   xcd_barrier(bar);
                pg8::Gemm g{HB, (const bf16*)(wl + (f ? LW_UP2 : LW_UP1)), M, NUP, D}; pg8::StaticOrder S; S.init(M, NUP, G, bx);
                pg8::EpiNull E{(float*)(ws + WS_CTL + 32768)};
                pg8::gemm_phase<pg8::EpiNull, pg8::StaticOrder, true, true>(lds, g, S, E);
            }
            PH_END_L(true);
            if (PH_ON) for (int rep = 0; rep < REP_DOWN; ++rep) {   if (rep) xcd_barrier(bar);
                pg8::Gemm g{R1, (const bf16*)(wl + (f ? LW_DN2 : LW_DN1)), M, D, FF, G_GAP}; pg8::StaticOrder S; S.init(M, D, G, bx);
                pg8::EpiRes E{(l == 0 && f == 0 && rep == 0) ? a.in[0] : nullptr, HB, ssq, rep ? 0.f : 0.5f};
                pg8::gemm_phase<pg8::EpiRes, pg8::StaticOrder, true, true>(lds, g, S, E);
            }
            PH_END_L(!(l == DEPTH - 1 && f == 1));
            if (f == 0) {
                if (PH_ON) for (int rep = 0; rep < REP_IN; ++rep) {   if (rep) xcd_barrier(bar);
                    pg8::Gemm g{HB, (const bf16*)(wl + LW_IN), M, INW, D}; pg8::StaticOrder S; S.init(M, INW, G, bx);
                    { int t_ = threadIdx.x; asm volatile("" : "+v"(t_)); const f32x4 bq = *(const GAS f32x4*)(a.in[7] + l * 2 * D + 4 * t_); *(LAS f32x4*)(lds + GB_OFF + 16 * t_) = bq; }
                    rstd_setup(lds, ssq, S);
                    pg8::EpiIn E{R1, (const LAS float*)(lds + RS_OFF), (const LAS float*)(lds + GB_OFF), INW, C_GA, 0};
                    pg8::gemm_phase<pg8::EpiIn, pg8::StaticOrder, true, true>(lds, g, S, E);
                }
                PH_END;
                if (PH_ON) for (int rep = 0; rep < REP_ATT; ++rep) {   if (rep) xcd_barrier(bar);
                    attn_phase(lds, R1, AO, tab, a.in[8] + l * 8, G, bx, local_ok);
                    {
                        const int run0 = local_ok ? (bx & 7) * 256 + (bx >> 3) * NWAVES + wave : gw, rstep = local_ok ? M : NGW;
                        for (int run = run0; run < M / 16; run += rstep) pool_run(R1, PL, run * 16, 16, lane);
                    }
                }
                PH_END_L(true);
                if (PH_ON) for (int rep = 0; rep < REP_BR; ++rep) {   if (rep) xcd_barrier(bar);
                    { pg8::Gemm g{AO, (const bf16*)(wl + LW_BA), M, D, 512}; pg8::StaticOrder S; S.init(M, D, G, bx);
                      pg8::EpiBr<true> E{R1, Z, INW, C_GA};
                      pg8::gemm_phase<pg8::EpiBr<true>, pg8::StaticOrder, true, true>(lds, g, S, E); }
                    { pg8::Gemm g{PL, (const bf16*)(wl + LW_BP), M, D, 512}; pg8::StaticOrder S; S.init(M, D, G, bx);
                      pg8::EpiBr<false> E{R1, Z, INW, C_GB};
                      pg8::gemm_phase<pg8::EpiBr<false>, pg8::StaticOrder, true, true>(lds, g, S, E); }
                }
                PH_END_L(true);
                if (PH_ON) for (int rep = 0; rep < REP_OUT; ++rep) {   if (rep) xcd_barrier(bar);
                    pg8::Gemm g{Z, (const bf16*)(wl + LW_OUT), M, D, D}; pg8::StaticOrder S; S.init(M, D, G, bx);
                    pg8::EpiRes E{nullptr, HB, ssq, rep ? 0.f : 1.0f};
                    pg8::gemm_phase<pg8::EpiRes, pg8::StaticOrder, true, true>(lds, g, S, E);
                }
                PH_END;
            }
        }
    }
    if (PH_ON) final_phase(a.out, (const bf16*)(ws + WS_HB), (const float*)(ws + WS_SSQ), a.in[18], gw, NGW, lane, M);
    PH_END;
}

extern "C" void kernel_launch(void* const* d_in, const int* in_sizes, int n_in, void* d_out, int out_size, void* d_ws, size_t ws_size, hipStream_t stream) {
    static int grid = 0;
    if (grid == 0) {
        if (n_in != 19 || out_size != M * D || ws_size < WS_END) { fprintf(stderr, "kernel_launch: unexpected shapes (n_in %d, out %d, ws %zu)\n", n_in, out_size, ws_size); grid = -1; return; }
        int dev = 0, cus = 0, per_cu = 0;
        (void)hipGetDevice(&dev); (void)hipDeviceGetAttribute(&cus, hipDeviceAttributeMultiprocessorCount, dev);
        if (hipFuncSetAttribute((const void*)mk_fwd, hipFuncAttributeMaxDynamicSharedMemorySize, LDS_BYTES) != hipSuccess) { fprintf(stderr, "kernel_launch: hipFuncSetAttribute failed\n"); grid = -1; return; }
        if (hipOccupancyMaxActiveBlocksPerMultiprocessor(&per_cu, (const void*)mk_fwd, NTHR, LDS_BYTES) != hipSuccess || per_cu < 1) { fprintf(stderr, "kernel_launch: occupancy query failed (%d)\n", per_cu); per_cu = 1; }
        (void)hipGetLastError();
        grid = cus * 1;
        fprintf(stderr, "kernel_launch: cus %d per_cu %d grid %d\n", cus, per_cu, grid);
    }
    if (grid < 0) return;
    if (hipMemsetAsync((char*)d_ws + WS_CTL, 0, 65536, stream) != hipSuccess) { fprintf(stderr, "kernel_launch: hipMemsetAsync failed\n"); return; }
    Args a{};
    for (int i = 0; i < 19; ++i) a.in[i] = (const float*)d_in[i];
    a.out = (float*)d_out; a.ws = (unsigned char*)d_ws;
#if MK_N_LAUNCHES == 1
    a.lo = 0; a.hi = NPH;
    void* args[] = {&a};
    hipError_t e = hipLaunchCooperativeKernel((const void*)mk_fwd, dim3(grid), dim3(NTHR), args, LDS_BYTES, stream);
    if (e != hipSuccess) fprintf(stderr, "kernel_launch: cooperative launch failed: %s (grid %d)\n", hipGetErrorString(e), grid);
#else
    for (int ph = 0; ph < NPH; ++ph) { a.lo = ph; a.hi = ph + 1; hipLaunchKernelGGL(mk_fwd, dim3(grid), dim3(NTHR), LDS_BYTES, stream, a); }
#endif
}
```

```cpp
#include <hip/hip_runtime.h>
#include <hip/hip_cooperative_groups.h>
#include <cstdio>
#include <cstdint>
namespace cg = cooperative_groups;
namespace pg8 {
#define PG8_LAS __attribute__((address_space(3)))
typedef unsigned short bf16_t;
typedef short bf16x8 __attribute__((ext_vector_type(8)));
typedef float f32x4 __attribute__((ext_vector_type(4)));
typedef unsigned u32x4 __attribute__((ext_vector_type(4)));
constexpr int BM = 256, BK = 64, HALF = 128, HTB = HALF * BK * 2  , STAGE_BYTES = 8 * HTB, NXCD = 8, WGM = 8;

__host__ __device__ __forceinline__ int lds_byte(int r, int c) { const int st = (r >> 4) * 2 + (c >> 5), rr = r & 15, cc = c & 31, ob = rr * 64 + cc * 2; return st * 1024 + (ob ^ (((ob >> 9) & 1) << 5)); }
__host__ __device__ __forceinline__ void stage_rc(int b, int& R, int& C) { const int st = b / 1024, sb = b % 1024, swz = sb ^ (((sb >> 9) & 1) << 5); R = (st >> 1) * 16 + swz / 64; C = (st & 1) * 32 + (swz % 64) / 2; }
__host__ __device__ __forceinline__ int perm32(int rho) { const int n = rho >> 4, i = rho & 15; return 8 * (i >> 2) + 4 * n + (i & 3); }

struct Unit { int pm, pn; };
struct Gemm { const bf16_t* A; const bf16_t* Bt; int M, N, K; size_t a_gap = 0; };

struct StaticOrder {
    int nM, nN, nwg, G, c;
    __host__ __device__ void init(int M, int N, int G_, int c_) { nM = M / BM; nN = N / BM; nwg = nM * nN; G = G_; c = c_; }
    __host__ __device__ bool next(int i, Unit& u) const {
        const long L = (long)i * G + c; if (L >= nwg) return false;
        int wgid = (int)L; { const int q = nwg / NXCD, r = nwg % NXCD, xcd = wgid % NXCD, off = wgid / NXCD; wgid = (xcd < r ? xcd * (q + 1) : r * (q + 1) + (xcd - r) * q) + off; }
        const int nig = WGM * nN, gid = wgid / nig, fm = gid * WGM, gsz = (nM - fm) < WGM ? (nM - fm) : WGM;
        u.pm = fm + ((wgid % nig) % gsz); u.pn = (wgid % nig) / gsz; return true;
    }
    __device__ __forceinline__ void a_ready(const Unit&) const {}
    __device__ __forceinline__ void done(const Unit&) const {}
};
__device__ __forceinline__ unsigned cvt_pk_bf16(float lo, float hi) { unsigned r; asm volatile("v_cvt_pk_bf16_f32 %0, %1, %2" : "=v"(r) : "v"(lo), "v"(hi)); return r; }
typedef float f32x2 __attribute__((ext_vector_type(2)));
#define PG8_GAS __attribute__((address_space(1)))
__device__ __forceinline__ float bf_lo(unsigned w) { return __uint_as_float(w << 16); }
__device__ __forceinline__ float bf_hi(unsigned w) { return __uint_as_float(w & 0xffff0000u); }
__device__ __forceinline__ float sigmoid_fast(float v) { return __builtin_amdgcn_rcpf(1.0f + __expf(-v)); }
__device__ __forceinline__ void rows_rstd(const PG8_LAS float* rst, int pm, int wr, int fr, float (&rs)[2][4]) {
    const PG8_LAS float* t = rst + ((pm >> 3) & 3) * 256 + wr * 64 + fr;
#pragma unroll
    for (int ai = 0; ai < 2; ++ai)
#pragma unroll
        for (int m = 0; m < 4; ++m) rs[ai][m] = t[ai * HALF + m * 16];
}
struct EpiNull {
    static constexpr bool PERM = true, AFTER_DRAIN = false;
    float* sink;
    __device__ __forceinline__ void operator()(const f32x4 (&acc)[2][2][4][2], const Unit& u, int wr, int wc, int fr, int fq) const {
        float s = 0.f;
#pragma unroll
        for (int ai = 0; ai < 2; ++ai)
#pragma unroll
            for (int bj = 0; bj < 2; ++bj)
#pragma unroll
                for (int m = 0; m < 4; ++m)
#pragma unroll
                    for (int n = 0; n < 2; ++n) s += acc[ai][bj][m][n][0];
        if (s == 1.2345e-33f) *sink = s;
    }
};
struct EpiUp {
    static constexpr bool PERM = true, AFTER_DRAIN = false;
    bf16_t* G; const PG8_LAS float* rst; int ldg; size_t xgap;
    __device__ __forceinline__ void operator()(const f32x4 (&acc)[2][2][4][2], const Unit& u, int wr, int wc, int fr, int fq) const {
        const int row0 = u.pm * BM + wr * 64 + fr, col0 = u.pn * HALF + wc * 32 + 8 * fq;
        float rs[2][4]; rows_rstd(rst, u.pm, wr, fr, rs);
#pragma unroll
        for (int ai = 0; ai < 2; ++ai)
#pragma unroll
            for (int m = 0; m < 4; ++m) {
                const int row = row0 + ai * HALF + m * 16; const float r = rs[ai][m], kk = r * -1.4426950408889634f, r2 = r * r;
                f32x4 o[2];
#pragma unroll
                for (int n = 0; n < 2; ++n) {
                    const f32x4 a = acc[ai][0][m][n], b = acc[ai][1][m][n];
                    const f32x4 t = a * kk;
                    f32x4 e; e[0] = __builtin_amdgcn_exp2f(t[0]); e[1] = __builtin_amdgcn_exp2f(t[1]); e[2] = __builtin_amdgcn_exp2f(t[2]); e[3] = __builtin_amdgcn_exp2f(t[3]);
                    const f32x4 d = e + 1.0f;
                    f32x4 q; q[0] = __builtin_amdgcn_rcpf(d[0]); q[1] = __builtin_amdgcn_rcpf(d[1]); q[2] = __builtin_amdgcn_rcpf(d[2]); q[3] = __builtin_amdgcn_rcpf(d[3]);
                    o[n] = (a * b) * (q * r2);
                }
                u32x4 w; w.x = cvt_pk_bf16(o[0][0], o[0][1]); w.y = cvt_pk_bf16(o[0][2], o[0][3]); w.z = cvt_pk_bf16(o[1][0], o[1][1]); w.w = cvt_pk_bf16(o[1][2], o[1][3]);
                *(PG8_GAS u32x4*)(G + (size_t)row * ldg + (size_t)(row >> 12) * xgap + col0) = w;
            }
    }
};
struct EpiIn {
    static constexpr bool PERM = true, AFTER_DRAIN = false;
    bf16_t* P; const PG8_LAS float* rst; const PG8_LAS float* bgate; int ldp, gate0, pnoff;
    __device__ __forceinline__ void operator()(const f32x4 (&acc)[2][2][4][2], const Unit& u, int wr, int wc, int fr, int fq) const {
        const int row0 = u.pm * BM + wr * 64 + fr, col0 = (u.pn + pnoff) * BM + wc * 32 + 8 * fq;
        const bool gate = ((u.pn + pnoff) * BM >= gate0);
        float rs[2][4]; rows_rstd(rst, u.pm, wr, fr, rs);
        f32x4 bv[2][2];
#pragma unroll
        for (int bj = 0; bj < 2; ++bj)
#pragma unroll
            for (int n = 0; n < 2; ++n) bv[bj][n] = gate ? *(const PG8_LAS f32x4*)(bgate + (col0 - gate0) + bj * HALF + 4 * n) : (f32x4){0.f, 0.f, 0.f, 0.f};
#pragma unroll
        for (int ai = 0; ai < 2; ++ai)
#pragma unroll
            for (int m = 0; m < 4; ++m) {
                const int row = row0 + ai * HALF + m * 16; const float r = rs[ai][m];
#pragma unroll
                for (int bj = 0; bj < 2; ++bj) {
                    f32x4 v0 = acc[ai][bj][m][0] * r + bv[bj][0], v1 = acc[ai][bj][m][1] * r + bv[bj][1];
                    if (gate) {
                        const f32x4 t0 = v0 * -1.4426950408889634f, t1 = v1 * -1.4426950408889634f;
                        f32x4 e0, e1;
#pragma unroll
                        for (int j = 0; j < 4; ++j) { e0[j] = __builtin_amdgcn_exp2f(t0[j]); e1[j] = __builtin_amdgcn_exp2f(t1[j]); }
                        const f32x4 d0 = e0 + 1.0f, d1 = e1 + 1.0f;
#pragma unroll
                        for (int j = 0; j < 4; ++j) { v0[j] = __builtin_amdgcn_rcpf(d0[j]); v1[j] = __builtin_amdgcn_rcpf(d1[j]); }
                    }
                    u32x4 w; w.x = cvt_pk_bf16(v0[0], v0[1]); w.y = cvt_pk_bf16(v0[2], v0[3]); w.z = cvt_pk_bf16(v1[0], v1[1]); w.w = cvt_pk_bf16(v1[2], v1[3]);
                    *(PG8_GAS u32x4*)(P + (size_t)row * ldp + col0 + bj * HALF) = w;
                }
            }
    }
};
struct EpiRes {
    static constexpr bool PERM = true, AFTER_DRAIN = false;
    const float* resf; bf16_t* hb; float* ssq; float alpha;
    __device__ __forceinline__ void operator()(const f32x4 (&acc)[2][2][4][2], const Unit& u, int wr, int wc, int fr, int fq) const {
        const int row0 = u.pm * BM + wr * 64 + fr, col0 = u.pn * BM + wc * 32 + 8 * fq;
        if (resf) {
#pragma unroll
            for (int ai = 0; ai < 2; ++ai)
#pragma unroll
                for (int m = 0; m < 4; ++m) {
                    const int row = row0 + ai * HALF + m * 16; const size_t off = (size_t)row * 1024 + col0;
                    float q = 0.f;
#pragma unroll
                    for (int bj = 0; bj < 2; ++bj) {
                        const f32x4 r0 = *(const PG8_GAS f32x4*)(resf + off + bj * HALF), r1 = *(const PG8_GAS f32x4*)(resf + off + bj * HALF + 4);
                        const f32x4 o0 = r0 + acc[ai][bj][m][0] * alpha, o1 = r1 + acc[ai][bj][m][1] * alpha;
                        u32x4 w; w.x = cvt_pk_bf16(o0[0], o0[1]); w.y = cvt_pk_bf16(o0[2], o0[3]); w.z = cvt_pk_bf16(o1[0], o1[1]); w.w = cvt_pk_bf16(o1[2], o1[3]);
                        *(PG8_GAS u32x4*)(hb + off + bj * HALF) = w;
                        q += (o0[0] * o0[0] + o0[1] * o0[1]) + (o0[2] * o0[2] + o0[3] * o0[3]) + (o1[0] * o1[0] + o1[1] * o1[1]) + (o1[2] * o1[2] + o1[3] * o1[3]);
                    }
                    q += __shfl_xor(q, 16); q += __shfl_xor(q, 32);
                    if (fq == 0) ssq[(size_t)row * 16 + u.pn * 4 + wc] = q;
                    if (m == 3) asm volatile("" ::: "memory");
                }
        } else {
#pragma unroll
            for (int ai = 0; ai < 2; ++ai) {
                u32x4 hw[4][2];
#pragma unroll
                for (int m = 0; m < 4; ++m)
#pragma unroll
                    for (int bj = 0; bj < 2; ++bj) hw[m][bj] = *(const PG8_GAS u32x4*)(hb + (size_t)(row0 + ai * HALF + m * 16) * 1024 + col0 + bj * HALF);
#pragma unroll
                for (int m = 0; m < 4; ++m) {
                    const int row = row0 + ai * HALF + m * 16; const size_t off = (size_t)row * 1024 + col0;
                    float q = 0.f;
#pragma unroll
                    for (int bj = 0; bj < 2; ++bj) {
                        const u32x4 h = hw[m][bj]; const f32x4 a0 = acc[ai][bj][m][0], a1 = acc[ai][bj][m][1];
                        float o[8];
                        o[0] = bf_lo(h.x) + a0[0] * alpha; o[1] = bf_hi(h.x) + a0[1] * alpha; o[2] = bf_lo(h.y) + a0[2] * alpha; o[3] = bf_hi(h.y) + a0[3] * alpha;
                        o[4] = bf_lo(h.z) + a1[0] * alpha; o[5] = bf_hi(h.z) + a1[1] * alpha; o[6] = bf_lo(h.w) + a1[2] * alpha; o[7] = bf_hi(h.w) + a1[3] * alpha;
                        u32x4 w; w.x = cvt_pk_bf16(o[0], o[1]); w.y = cvt_pk_bf16(o[2], o[3]); w.z = cvt_pk_bf16(o[4], o[5]); w.w = cvt_pk_bf16(o[6], o[7]);
                        *(PG8_GAS u32x4*)(hb + off + bj * HALF) = w;
                        q += (o[0] * o[0] + o[1] * o[1]) + (o[2] * o[2] + o[3] * o[3]) + (o[4] * o[4] + o[5] * o[5]) + (o[6] * o[6] + o[7] * o[7]);
                    }
                    q += __shfl_xor(q, 16); q += __shfl_xor(q, 32);
                    if (fq == 0) ssq[(size_t)row * 16 + u.pn * 4 + wc] = q;
                }
                asm volatile("" ::: "memory");
            }
        }
    }
};
template <bool FIRST> struct EpiBr {
    static constexpr bool PERM = true, AFTER_DRAIN = false;
    const bf16_t* P; bf16_t* Z; int ldp, goff;
    __device__ __forceinline__ void operator()(const f32x4 (&acc)[2][2][4][2], const Unit& u, int wr, int wc, int fr, int fq) const {
        const int row0 = u.pm * BM + wr * 64 + fr, col0 = u.pn * BM + wc * 32 + 8 * fq;
#pragma unroll
        for (int ai = 0; ai < 2; ++ai)
#pragma unroll
            for (int m = 0; m < 4; ++m) {
                const int row = row0 + ai * HALF + m * 16;
#pragma unroll
                for (int bj = 0; bj < 2; ++bj) {
                    const u32x4 gw = *(const PG8_GAS u32x4*)(P + (size_t)row * ldp + goff + col0 + bj * HALF);
                    bf16_t* zp = Z + (size_t)row * 1024 + col0 + bj * HALF;
                    const f32x4 a0 = acc[ai][bj][m][0], a1 = acc[ai][bj][m][1];
                    float o[8];
                    o[0] = bf_lo(gw.x) * a0[0]; o[1] = bf_hi(gw.x) * a0[1]; o[2] = bf_lo(gw.y) * a0[2]; o[3] = bf_hi(gw.y) * a0[3];
                    o[4] = bf_lo(gw.z) * a1[0]; o[5] = bf_hi(gw.z) * a1[1]; o[6] = bf_lo(gw.w) * a1[2]; o[7] = bf_hi(gw.w) * a1[3];
                    if (!FIRST) {
                        const u32x4 zw = *(const PG8_GAS u32x4*)zp;
                        o[0] += bf_lo(zw.x); o[1] += bf_hi(zw.x); o[2] += bf_lo(zw.y); o[3] += bf_hi(zw.y);
                        o[4] += bf_lo(zw.z); o[5] += bf_hi(zw.z); o[6] += bf_lo(zw.w); o[7] += bf_hi(zw.w);
                    }
                    u32x4 w; w.x = cvt_pk_bf16(o[0], o[1]); w.y = cvt_pk_bf16(o[2], o[3]); w.z = cvt_pk_bf16(o[4], o[5]); w.w = cvt_pk_bf16(o[6], o[7]);
                    *(PG8_GAS u32x4*)zp = w;
                }
                if (m == 3) asm volatile("" ::: "memory");
            }
    }
};
template <class Epi, class Sched, bool ALIGN_EPI = false, bool SP2 = false>
__device__ __forceinline__ void gemm_phase(PG8_LAS unsigned char* lds, const Gemm g, const Sched& S, const Epi& E) {
    int tid_ = threadIdx.x; asm volatile("" : "+v"(tid_)); const int tid = tid_, wid = __builtin_amdgcn_readfirstlane(tid >> 6), lane = tid & 63, wr = wid >> 2, wc = wid & 3, fr = lane & 15, fq = lane >> 4;
    const int K = g.K, nt = K / BK;
    unsigned voffA[2], voffB[2];
#pragma unroll
    for (int i = 0; i < 2; ++i) { int R, C; stage_rc(tid * 16 + i * 8192, R, C); const int Rb = Epi::PERM ? ((R & ~31) + perm32(R & 31)) : R;
        voffA[i] = (unsigned)(R * K + C) * 2u; voffB[i] = (unsigned)(Rb * K + C) * 2u; }
    const size_t kstep = (size_t)(BK * 2);
    const size_t hstep = (size_t)HALF * K * 2;
    const size_t tstep = 2 * hstep;
    const unsigned ldsw = (unsigned)wid * 1024u;
    const int aoff = lds_byte(wr * 64 + fr, fq * 8), boff = lds_byte(wc * 32 + fr, fq * 8);
#define PG8_SA(b, h) (((b) * 2 + (h)) * HTB)
#define PG8_SB(b, h) ((4 + (b) * 2 + (h)) * HTB)
#define PG8_STAGE(bufoff, gbase, voff) do { _Pragma("unroll") for (int _i = 0; _i < 2; ++_i) \
        __builtin_amdgcn_global_load_lds((const unsigned*)((const char*)(gbase) + (voff)[_i]), (PG8_LAS unsigned*)(lds + (bufoff) + ldsw + _i * 8192), 16, 0, 0); } while (0)
#define PG8_LDA(dst, b, h) do { _Pragma("unroll") for (int m = 0; m < 4; ++m) _Pragma("unroll") for (int k = 0; k < 2; ++k) dst[m][k] = *(const PG8_LAS bf16x8*)(lds + PG8_SA(b, h) + aoff + m * 2048 + k * 1024); } while (0)
#define PG8_LDB(dst, b, h) do { _Pragma("unroll") for (int n = 0; n < 2; ++n) _Pragma("unroll") for (int k = 0; k < 2; ++k) dst[n][k] = *(const PG8_LAS bf16x8*)(lds + PG8_SB(b, h) + boff + n * 2048 + k * 1024); } while (0)
#define PG8_MMA(ai, bj, At, Bt) do { __builtin_amdgcn_s_setprio(1); _Pragma("unroll") for (int m = 0; m < 4; ++m) _Pragma("unroll") for (int n = 0; n < 2; ++n) _Pragma("unroll") for (int k = 0; k < 2; ++k) \
        acc[ai][bj][m][n] = __builtin_amdgcn_mfma_f32_16x16x32_bf16(Bt[n][k], At[m][k], acc[ai][bj][m][n], 0, 0, 0); __builtin_amdgcn_s_setprio(0); } while (0)
#define PG8_WAIT_V(n) asm volatile("s_waitcnt vmcnt(" #n ")" ::: "memory")
#define PG8_WAIT_L(n) asm volatile("s_waitcnt lgkmcnt(" #n ")" ::: "memory")
#define PG8_BAR __builtin_amdgcn_s_barrier()
#define PG8_SCHED __builtin_amdgcn_sched_barrier(0)
    Unit cur, nxt; int ui = 0;
    if (!S.next(0, cur)) return;
    f32x4 acc[2][2][4][2];
#pragma unroll
    for (int a = 0; a < 2; ++a)
#pragma unroll
        for (int b = 0; b < 2; ++b)
#pragma unroll
            for (int m = 0; m < 4; ++m)
#pragma unroll
                for (int n = 0; n < 2; ++n) acc[a][b][m][n] = (f32x4){0.f, 0.f, 0.f, 0.f};
    bf16x8 At[4][2], B0[2][2], B1[2][2];
    const char* cA = (const char*)g.A + (size_t)cur.pm * tstep + (size_t)(cur.pm >> 4) * g.a_gap; const char* cB = (const char*)g.Bt + (size_t)cur.pn * tstep;
    S.a_ready(cur);
    if constexpr (SP2) {
        PG8_STAGE(PG8_SB(0, 0), cB, voffB); PG8_STAGE(PG8_SB(0, 1), cB + hstep, voffB); PG8_STAGE(PG8_SA(0, 0), cA, voffA); PG8_STAGE(PG8_SA(0, 1), cA + hstep, voffA);
        if (wr == 1) PG8_BAR;
        PG8_WAIT_V(2); PG8_BAR;
        PG8_STAGE(PG8_SB(1, 0), cB + kstep, voffB); PG8_STAGE(PG8_SA(1, 0), cA + kstep, voffA); PG8_STAGE(PG8_SB(1, 1), cB + hstep + kstep, voffB);
        PG8_WAIT_V(6); PG8_BAR;
    } else {
        PG8_STAGE(PG8_SB(0, 0), cB, voffB); PG8_STAGE(PG8_SA(0, 0), cA, voffA); PG8_STAGE(PG8_SB(0, 1), cB + hstep, voffB); PG8_STAGE(PG8_SA(0, 1), cA + hstep, voffA);
        if (wr == 1) PG8_BAR;
        PG8_WAIT_V(4); PG8_BAR;
        PG8_STAGE(PG8_SB(1, 0), cB + kstep, voffB); PG8_STAGE(PG8_SA(1, 0), cA + kstep, voffA); PG8_STAGE(PG8_SB(1, 1), cB + hstep + kstep, voffB);
        PG8_WAIT_V(6); PG8_BAR;
    }
    for (;;) {
        const bool has_next = S.next(ui + 1, nxt);
        const char* nA = has_next ? (const char*)g.A + (size_t)nxt.pm * tstep + (size_t)(nxt.pm >> 4) * g.a_gap : cA; const char* nB = has_next ? (const char*)g.Bt + (size_t)nxt.pn * tstep : cB;
        for (int t = 0; t < nt; t += 2) {
            const bool last = (t == nt - 2);
            const char* a1 = cA + (size_t)(t + 1) * kstep;
            const char* a2 = last ? nA : cA + (size_t)(t + 2) * kstep; const char* b2 = last ? nB : cB + (size_t)(t + 2) * kstep;
            const char* a3 = a2 + kstep; const char* b3 = b2 + kstep;
            if (last && has_next) S.a_ready(nxt);
            if constexpr (SP2) {
            PG8_LDB(B0, 0, 0); PG8_LDB(B1, 0, 1); PG8_SCHED; PG8_LDA(At, 0, 0); PG8_STAGE(PG8_SA(1, 1), a1 + hstep, voffA);
            PG8_WAIT_V(8); PG8_WAIT_L(0); PG8_BAR; PG8_MMA(0, 0, At, B0); PG8_MMA(0, 1, At, B1); PG8_BAR; PG8_SCHED;
            PG8_LDA(At, 0, 1); PG8_STAGE(PG8_SB(0, 0), b2, voffB); PG8_STAGE(PG8_SB(0, 1), b2 + hstep, voffB); PG8_STAGE(PG8_SA(0, 0), a2, voffA);
            PG8_WAIT_V(8); PG8_WAIT_L(0); PG8_BAR; PG8_MMA(1, 0, At, B0); PG8_MMA(1, 1, At, B1); PG8_BAR; PG8_SCHED;
            PG8_LDB(B0, 1, 0); PG8_LDB(B1, 1, 1); PG8_SCHED; PG8_LDA(At, 1, 0); PG8_STAGE(PG8_SA(0, 1), a2 + hstep, voffA);
            PG8_WAIT_V(8); PG8_WAIT_L(0); PG8_BAR; PG8_MMA(0, 0, At, B0); PG8_MMA(0, 1, At, B1); PG8_BAR; PG8_SCHED;
            PG8_LDA(At, 1, 1); PG8_STAGE(PG8_SB(1, 0), b3, voffB); PG8_STAGE(PG8_SB(1, 1), b3 + hstep, voffB); PG8_STAGE(PG8_SA(1, 0), a3, voffA);
            PG8_WAIT_V(8); PG8_WAIT_L(0); PG8_BAR; PG8_MMA(1, 0, At, B0); PG8_MMA(1, 1, At, B1); PG8_BAR; PG8_SCHED;
            } else {
            PG8_LDB(B0, 0, 0); PG8_SCHED; PG8_LDA(At, 0, 0); PG8_STAGE(PG8_SA(1, 1), a1 + hstep, voffA);
            PG8_WAIT_L(8); PG8_BAR; PG8_WAIT_L(0); PG8_MMA(0, 0, At, B0); PG8_BAR; PG8_SCHED;
            PG8_LDB(B1, 0, 1); PG8_STAGE(PG8_SB(0, 0), b2, voffB);
            PG8_BAR; PG8_WAIT_L(0); PG8_MMA(0, 1, At, B1); PG8_BAR;
            PG8_LDA(At, 0, 1); PG8_STAGE(PG8_SA(0, 0), a2, voffA);
            PG8_BAR; PG8_WAIT_L(0); PG8_MMA(1, 0, At, B0); PG8_BAR; PG8_SCHED;
            PG8_STAGE(PG8_SB(0, 1), b2 + hstep, voffB);
            PG8_WAIT_V(6); PG8_BAR; PG8_MMA(1, 1, At, B1); PG8_BAR;
            PG8_LDB(B0, 1, 0); PG8_SCHED; PG8_LDA(At, 1, 0); PG8_STAGE(PG8_SA(0, 1), a2 + hstep, voffA);
            PG8_WAIT_L(8); PG8_BAR; PG8_WAIT_L(0); PG8_MMA(0, 0, At, B0); PG8_BAR; PG8_SCHED;
            PG8_LDB(B1, 1, 1); PG8_STAGE(PG8_SB(1, 0), b3, voffB);
            PG8_BAR; PG8_WAIT_L(0); PG8_MMA(0, 1, At, B1); PG8_BAR;
            PG8_LDA(At, 1, 1); PG8_STAGE(PG8_SA(1, 0), a3, voffA);
            PG8_BAR; PG8_WAIT_L(0); PG8_MMA(1, 0, At, B0); PG8_BAR; PG8_SCHED;
            PG8_STAGE(PG8_SB(1, 1), b3 + hstep, voffB);
            PG8_WAIT_V(6); PG8_BAR; PG8_MMA(1, 1, At, B1); PG8_BAR;
            }
        }
        if constexpr (ALIGN_EPI) { if (wr == 0) PG8_BAR; }
        if constexpr (!Epi::AFTER_DRAIN) { E(acc, cur, wr, wc, fr, fq); S.done(cur); }
        if (!has_next) break;
#pragma unroll
        for (int a = 0; a < 2; ++a)
#pragma unroll
            for (int b = 0; b < 2; ++b)
#pragma unroll
                for (int m = 0; m < 4; ++m)
#pragma unroll
                    for (int n = 0; n < 2; ++n) acc[a][b][m][n] = (f32x4){0.f, 0.f, 0.f, 0.f};
        cur = nxt; cA = nA; cB = nB; ++ui;
        if constexpr (ALIGN_EPI) { if (wr == 1) PG8_BAR; }
    }
    PG8_WAIT_V(0);
    if constexpr (!ALIGN_EPI) { if (wr == 0) PG8_BAR; }
    PG8_BAR;
    if constexpr (Epi::AFTER_DRAIN) { E.fused(acc, cur, wr, wc, fr, fq, lds, wid, lane); S.done(cur); }
#undef PG8_SA
#undef PG8_SB
#undef PG8_STAGE
#undef PG8_LDA
#undef PG8_LDB
#undef PG8_MMA
#undef PG8_WAIT_V
#undef PG8_WAIT_L
#undef PG8_BAR
#undef PG8_SCHED
}
}
#define GAS __attribute__((address_space(1)))
#define LAS __attribute__((address_space(3)))
typedef unsigned short bf16;
typedef unsigned u32x4 __attribute__((ext_vector_type(4)));
typedef unsigned u32x2 __attribute__((ext_vector_type(2)));
typedef float f32x4 __attribute__((ext_vector_type(4)));
typedef short bf16x8 __attribute__((ext_vector_type(8)));
constexpr int NWAVES = 8, NTHR = 512;
constexpr int BATCH = 4, SEQ = 8192, D = 1024, M = BATCH * SEQ, FF = 2816, NUP = 2 * FF, INW = 3328, DEPTH = 2;
constexpr int C_Q = 0, C_K = 512, C_V = 640, C_P = 768, C_GA = 1280, C_GB = 2304;
constexpr int LDS_BYTES = 147456;
constexpr size_t MiB = 1u << 20;
constexpr size_t WS_CTL = 0;
constexpr size_t WS_TAB = 1 * MiB;
constexpr size_t WS_BIAS = 1 * MiB + 512 * 1024;
constexpr size_t WS_SSQ = 2 * MiB;
constexpr size_t WS_W = 4 * MiB;
constexpr size_t W_UP = (size_t)NUP * D * 2, W_DN = (size_t)D * FF * 2, W_IN = (size_t)INW * D * 2, W_BR = (size_t)D * 512 * 2, W_OUT = (size_t)D * D * 2;
constexpr size_t LW_UP1 = 0, LW_DN1 = LW_UP1 + W_UP, LW_IN = LW_DN1 + W_DN, LW_BA = LW_IN + W_IN, LW_BP = LW_BA + W_BR, LW_OUT = LW_BP + W_BR, LW_UP2 = LW_OUT + W_OUT, LW_DN2 = LW_UP2 + W_UP, LW = LW_DN2 + W_DN;
static_assert(LW % 256 == 0 && WS_W + 2 * LW <= 100 * MiB, "weights");
constexpr size_t WS_HB = 100 * MiB;
constexpr size_t OUT_AO = 0, OUT_PL = 32 * MiB;
constexpr size_t WS_R1 = 164 * MiB;
constexpr size_t WS_Z = 372 * MiB;
constexpr size_t WS_AOPL = 436 * MiB;
constexpr size_t WS_END = 500 * MiB;
static_assert(WS_R1 + (size_t)M * INW * 2 <= WS_Z, "ws map");
constexpr size_t G_GAP = (size_t)4096 * (INW - FF) * 2;

__device__ __forceinline__ unsigned f2bf(float f) { unsigned u = __builtin_bit_cast(unsigned, f); return (u + 0x7fffu + ((u >> 16) & 1u)) >> 16; }
__device__ __forceinline__ unsigned pk2(float lo, float hi) { return f2bf(lo) | (f2bf(hi) << 16); }
__device__ __forceinline__ float bflo(unsigned w) { return __uint_as_float(w << 16); }
__device__ __forceinline__ float bfhi(unsigned w) { return __uint_as_float(w & 0xffff0000u); }
__device__ __forceinline__ void unpack8(const u32x4 w, float (&x)[8]) { x[0] = bflo(w.x); x[1] = bfhi(w.x); x[2] = bflo(w.y); x[3] = bfhi(w.y); x[4] = bflo(w.z); x[5] = bfhi(w.z); x[6] = bflo(w.w); x[7] = bfhi(w.w); }
__device__ __forceinline__ u32x4 pack8(const float (&x)[8]) { u32x4 w; w.x = pk2(x[0], x[1]); w.y = pk2(x[2], x[3]); w.z = pk2(x[4], x[5]); w.w = pk2(x[6], x[7]); return w; }
__device__ __forceinline__ float wave_sum(float v) {
#pragma unroll
    for (int o = 1; o < 64; o <<= 1) v += __shfl_xor(v, o);
    return v;
}
#define LDS_WAIT() asm volatile("s_waitcnt lgkmcnt(0)" ::: "memory")

__device__ __forceinline__ void transpose_item(const float* W, int K, int N, bf16* WT, const float* gk, int il, LAS float* scr, int item, int lane) {
    const int nblk = N / 32, kb = item / nblk, nb = item % nblk, k0 = 64 * kb, n0 = 32 * nb;
    const GAS float* Wg = (const GAS float*)W + (size_t)k0 * N + n0 + (lane & 31); const GAS float* gg = (const GAS float*)gk + k0;
    float v[32];
#pragma unroll
    for (int i = 0; i < 32; ++i) v[i] = Wg[(size_t)(2 * i + (lane >> 5)) * N];
    if (gk) {
#pragma unroll
        for (int i = 0; i < 32; ++i) v[i] *= gg[2 * i + (lane >> 5)];
    }
#pragma unroll
    for (int i = 0; i < 32; ++i) scr[(2 * i + (lane >> 5)) * 33 + (lane & 31)] = v[i];
    LDS_WAIT(); asm volatile("" ::: "memory");
    const int c = lane & 7;
#pragma unroll
    for (int j = 0; j < 4; ++j) { const int n = (lane >> 3) + 8 * j; const LAS float* s = scr + (8 * c) * 33 + n;
        u32x4 o; o.x = pk2(s[0 * 33], s[1 * 33]); o.y = pk2(s[2 * 33], s[3 * 33]); o.z = pk2(s[4 * 33], s[5 * 33]); o.w = pk2(s[6 * 33], s[7 * 33]);
        const int nn = n0 + n, drow = il < 0 ? nn : 256 * (nn >> 7) + (nn & 127) + il;
        *(GAS u32x4*)(WT + (size_t)drow * K + k0 + 8 * c) = o; }
    LDS_WAIT(); asm volatile("" ::: "memory");
}
struct Args { const float* in[19]; float* out; unsigned char* ws; int lo, hi; };
__device__ __forceinline__ void prep_phase(const Args& P, LAS unsigned char* lds, int gw, int NGW, int lane, int gtid, int NT, int parts) {
    LAS float* scr = (LAS float*)(lds + (threadIdx.x >> 6) * 16384);
    constexpr int I_UP = (D / 64) * (FF / 32), I_DN = (FF / 64) * (D / 32), I_IN = (D / 64) * (INW / 32), I_BA = (512 / 64) * (D / 32), I_OUT = (D / 64) * (D / 32);
    constexpr int I_LAYER = 4 * I_UP + 2 * I_DN + I_IN + I_BA + I_OUT;
    if (parts & 1) for (int it = gw; it < DEPTH * I_LAYER; it += NGW) {
        const int l = it / I_LAYER; int r = it % I_LAYER;
        unsigned char* wl = P.ws + WS_W + (size_t)l * LW;
        if (r < I_UP) { transpose_item(P.in[2] + (size_t)l * D * FF, D, FF, (bf16*)(wl + LW_UP1), P.in[1] + l * D, 0, scr, r, lane); continue; } r -= I_UP;
        if (r < I_UP) { transpose_item(P.in[3] + (size_t)l * D * FF, D, FF, (bf16*)(wl + LW_UP1), P.in[1] + l * D, 128, scr, r, lane); continue; } r -= I_UP;
        if (r < I_DN) { transpose_item(P.in[4] + (size_t)l * FF * D, FF, D, (bf16*)(wl + LW_DN1), nullptr, -1, scr, r, lane); continue; } r -= I_DN;
        if (r < I_IN) { transpose_item(P.in[6] + (size_t)l * D * INW, D, INW, (bf16*)(wl + LW_IN), P.in[5] + l * D, -1, scr, r, lane); continue; } r -= I_IN;
        if (r < I_BA) { transpose_item(P.in[11] + (size_t)l * 512 * D, 512, D, (bf16*)(wl + LW_BA), nullptr, -1, scr, r, lane); continue; } r -= I_BA;
        if (r < I_OUT) { transpose_item(P.in[13] + (size_t)l * D * D, D, D, (bf16*)(wl + LW_OUT), nullptr, -1, scr, r, lane); continue; } r -= I_OUT;
        if (r < I_UP) { transpose_item(P.in[15] + (size_t)l * D * FF, D, FF, (bf16*)(wl + LW_UP2), P.in[14] + l * D, 0, scr, r, lane); continue; } r -= I_UP;
        if (r < I_UP) { transpose_item(P.in[16] + (size_t)l * D * FF, D, FF, (bf16*)(wl + LW_UP2), P.in[14] + l * D, 128, scr, r, lane); continue; } r -= I_UP;
        transpose_item(P.in[17] + (size_t)l * FF * D, FF, D, (bf16*)(wl + LW_DN2), nullptr, -1, scr, r, lane);
    }
    if (parts & 2) for (int it = gw; it < DEPTH * 64 * 16; it += NGW) {
        const int l = __builtin_amdgcn_readfirstlane(it >> 10), co = __builtin_amdgcn_readfirstlane((it >> 4) & 63), n = (it & 15) * 64 + lane, c0 = co * 8, g = c0 >> 7;
        const GAS float* pw = (const GAS float*)P.in[9] + ((size_t)l * 512 + c0) * 128 + 2 * lane;
        const GAS float* sc = (const GAS float*)P.in[10] + l * 512 + g * 128 + 2 * lane;
        const GAS float* wb = (const GAS float*)P.in[12] + ((size_t)l * 512 + g * 128) * D + n;
        const float s0 = sc[0], s1 = sc[1];
        float pws[8][2];
#pragma unroll
        for (int j = 0; j < 8; ++j) { pws[j][0] = pw[j * 128] * s0; pws[j][1] = pw[j * 128 + 1] * s1; }
        float acc[8];
#pragma unroll
        for (int j = 0; j < 8; ++j) acc[j] = 0.f;
#pragma unroll
        for (int d = 0; d < 128; ++d) {
            const float w = wb[(size_t)d * D];
#pragma unroll
            for (int j = 0; j < 8; ++j) acc[j] += __uint_as_float(__builtin_amdgcn_readlane(__float_as_uint(pws[j][d & 1]), d >> 1)) * w;
        }
        *(GAS u32x4*)((bf16*)(P.ws + WS_W + (size_t)l * LW + LW_BP) + (size_t)n * 512 + c0) = pack8(acc);
    }
    if (parts & 4) for (int idx = gtid; idx < DEPTH * INW; idx += NT) { const int l = idx / INW, c = idx % INW; ((float*)(P.ws + WS_BIAS))[idx] = c >= C_GA ? P.in[7][l * 2 * D + c - C_GA] : 0.f; }
    if (parts & 4) for (int idx = gtid; idx < SEQ * 8; idx += NT) {
        const int pos = idx >> 3, i = idx & 7;
        const float pf = (float)pow(500000.0, (double)(2 * i) / 16.0);
        const float inv = 1.0f / pf;
        const float ang = (float)pos * inv;
        const double x = (double)ang;
        const double kd = rint(x * 0.63661977236758134308);
        const double r = fma(-kd, 6.123233995736766035868820147292e-17, fma(-kd, 1.5707963267948965580, x));
        const double r2 = r * r;
        double sp = 1.0 / 6227020800.0; sp = sp * r2 * -1.0 + 1.0 / 39916800.0; sp = -sp * r2 + 1.0 / 362880.0; sp = -sp * r2 + 1.0 / 5040.0; sp = -sp * r2 + 1.0 / 120.0; sp = -sp * r2 + 1.0 / 6.0; sp = -sp * r2 + 1.0;
        const double sr = sp * r;
        double cp = 1.0 / 479001600.0; cp = -cp * r2 + 1.0 / 3628800.0; cp = -cp * r2 + 1.0 / 40320.0; cp = -cp * r2 + 1.0 / 720.0; cp = -cp * r2 + 1.0 / 24.0; cp = -cp * r2 + 0.5; cp = -cp * r2 + 1.0;
        const int q = ((int)kd) & 3;
        const double cs = (q == 0) ? cp : (q == 1) ? -sr : (q == 2) ? -cp : sr;
        const double sn = (q == 0) ? sr : (q == 1) ? cp : (q == 2) ? -sr : -cp;
        float* tab = (float*)(P.ws + WS_TAB);
        tab[pos * 16 + i] = (float)cs; tab[pos * 16 + 8 + i] = (float)sn;
    }
    if (parts & 8) for (int m = gw; m < M; m += 2 * NGW) {
        f32x4 v[2][4]; float s[2];
#pragma unroll
        for (int r = 0; r < 2; ++r) { const GAS f32x4* xr = (const GAS f32x4*)(P.in[0] + (size_t)(m + r * NGW) * D) + lane;
#pragma unroll
            for (int j = 0; j < 4; ++j) v[r][j] = xr[64 * j]; }
#pragma unroll
        for (int r = 0; r < 2; ++r) { float q = 0.f;
#pragma unroll
            for (int j = 0; j < 4; ++j) q += (v[r][j][0] * v[r][j][0] + v[r][j][1] * v[r][j][1]) + (v[r][j][2] * v[r][j][2] + v[r][j][3] * v[r][j][3]);
            s[r] = wave_sum(q); }
#pragma unroll
        for (int r = 0; r < 2; ++r) { const int mm = m + r * NGW; GAS u32x2* o8 = (GAS u32x2*)(P.ws + WS_HB + (size_t)mm * D * 2) + lane;
#pragma unroll
            for (int j = 0; j < 4; ++j) { u32x2 w; w.x = pk2(v[r][j][0], v[r][j][1]); w.y = pk2(v[r][j][2], v[r][j][3]); o8[64 * j] = w; }
            if (lane < 16) ((GAS float*)(P.ws + WS_SSQ))[(size_t)mm * 16 + lane] = lane == 0 ? s[r] : 0.f; }
    }
}

constexpr int KP = 144, VP = 784, OFF_V = 384 * KP;
static_assert(OFF_V + 64 * VP <= 131072, "attention LDS");
__device__ __forceinline__ bf16x8 as_bf16x8(u32x4 w) { return __builtin_bit_cast(bf16x8, w); }
__device__ __forceinline__ u32x4 pack_p(const f32x4 a, const f32x4 b) {
    u32x4 p;
    asm volatile("v_cvt_pk_bf16_f32 %0, %4, %5\n\tv_cvt_pk_bf16_f32 %1, %6, %7\n\tv_cvt_pk_bf16_f32 %2, %8, %9\n\tv_cvt_pk_bf16_f32 %3, %10, %11\n\ts_nop 1"
                 : "=&v"(p.x), "=&v"(p.y), "=&v"(p.z), "=&v"(p.w)
                 : "v"(a[0]), "v"(a[1]), "v"(a[2]), "v"(a[3]), "v"(b[0]), "v"(b[1]), "v"(b[2]), "v"(b[3]));
    return p;
}
__device__ __forceinline__ void attn_phase(LAS unsigned char* lds, const bf16* PROJ, bf16* AO, const float* tab, const float* sink, int G, int c0, bool own) {
    int tid_ = threadIdx.x; asm volatile("" : "+v"(tid_));
    const int tid = tid_, wid = __builtin_amdgcn_readfirstlane(tid >> 6), lane = tid & 63, fr = lane & 15, fq = lane >> 4;
    const float SC = 0.125f * 1.4426950408889634f, L2E = 1.4426950408889634f;
    const int u_first = own ? ((((c0 & 7) * 32 + (c0 >> 3)) << 1)) : c0, u_step = own ? 1 : G, u_end = own ? u_first + 2 : BATCH * 64 * 2;
    for (int u = u_first; u < u_end; u += u_step) {
        const int kvh = u & 1, blk = (u >> 1) & 63, b = u >> 7;
        const int h = kvh * 4 + (wid >> 1);
        const bf16* qbase = PROJ + ((size_t)b * SEQ + blk * 128 + (wid & 1) * 64 + fr) * INW + C_Q + h * 64 + 8 * fq;
        u32x4 qn0 = *(const GAS u32x4*)qbase, qn1 = *(const GAS u32x4*)(qbase + 32);
        __syncthreads();
#pragma unroll
        for (int it = 0; it < 6; ++it) {
            const int p = it * NTHR + tid, row = p >> 3, pc = p & 7;
            const int kpos = blk * 128 - 128 + row;
            const bool ok = (kpos >= 0) && (kpos < SEQ);
            const int kp = ok ? kpos : 0;
            const bf16* src = PROJ + (size_t)(b * SEQ + kp) * INW + C_K + kvh * 64 + pc * 8;
            u32x4 kw = *(const GAS u32x4*)src;
            if (!ok) kw = (u32x4){0u, 0u, 0u, 0u};
            float x[8], y[8]; unpack8(kw, x);
#pragma unroll
            for (int j = 0; j < 8; ++j) y[j] = __shfl_xor(x[j], 1);
            if (pc < 2) {
                const GAS f32x4* tp = (const GAS f32x4*)(tab + kp * 16);
                const f32x4 ca = tp[0], cb = tp[1], sa = tp[2], sb = tp[3];
                const float sg = pc == 0 ? -1.f : 1.f;
#pragma unroll
                for (int j = 0; j < 4; ++j) { x[j] = x[j] * ca[j] + sg * y[j] * sa[j]; x[4 + j] = x[4 + j] * cb[j] + sg * y[4 + j] * sb[j]; }
                kw = pack8(x);
            }
            *(LAS u32x4*)(lds + row * KP + pc * 16) = kw;
        }
#pragma unroll
        for (int it = 0; it < 6; ++it) {
            const int p = it * NTHR + tid, pc = p / 384, row = p - pc * 384;
            const int kpos = blk * 128 - 128 + row;
            const bool ok = (kpos >= 0) && (kpos < SEQ);
            const int kp = ok ? kpos : 0;
            u32x4 vw = *(const GAS u32x4*)(PROJ + (size_t)(b * SEQ + kp) * INW + C_V + kvh * 64 + pc * 8);
            if (!ok) vw = (u32x4){0u, 0u, 0u, 0u};
            LAS unsigned short* vt = (LAS unsigned short*)(lds + OFF_V) + (pc * 8) * (VP / 2) + row;
            vt[0 * (VP / 2)] = (unsigned short)(vw.x & 0xffffu); vt[1 * (VP / 2)] = (unsigned short)(vw.x >> 16);
            vt[2 * (VP / 2)] = (unsigned short)(vw.y & 0xffffu); vt[3 * (VP / 2)] = (unsigned short)(vw.y >> 16);
            vt[4 * (VP / 2)] = (unsigned short)(vw.z & 0xffffu); vt[5 * (VP / 2)] = (unsigned short)(vw.z >> 16);
            vt[6 * (VP / 2)] = (unsigned short)(vw.w & 0xffffu); vt[7 * (VP / 2)] = (unsigned short)(vw.w >> 16);
        }
        __syncthreads();
        const float sink2 = sink[h] * L2E;
        const bool edge = (blk == 0) || (blk == 63);
#pragma unroll 1
        for (int i = 0; i < 4; ++i) {
            const int r0 = ((wid & 1) * 4 + i) * 16, r = r0 + fr, pos = blk * 128 + r;
            const size_t mq = (size_t)b * SEQ + pos;
            u32x4 q0 = qn0; const u32x4 q1 = qn1;
            { const bf16* qp = qbase + (size_t)(i < 3 ? i + 1 : i) * 16 * INW; qn0 = *(const GAS u32x4*)qp; qn1 = *(const GAS u32x4*)(qp + 32); }
            {
                float x[8], y[8]; unpack8(q0, x);
#pragma unroll
                for (int j = 0; j < 8; ++j) y[j] = __shfl_xor(x[j], 16);
                if (fq < 2) {
                    const GAS f32x4* tp = (const GAS f32x4*)(tab + pos * 16);
                    const f32x4 ca = tp[0], cb = tp[1], sa = tp[2], sb = tp[3];
                    const float sg = fq == 0 ? -1.f : 1.f;
#pragma unroll
                    for (int j = 0; j < 4; ++j) { x[j] = x[j] * ca[j] + sg * y[j] * sa[j]; x[4 + j] = x[4 + j] * cb[j] + sg * y[4 + j] * sb[j]; }
                    q0 = pack8(x);
                }
            }
            const bf16x8 Q0 = as_bf16x8(q0), Q1 = as_bf16x8(q1);
            const int kst = r0 < 96 ? r0 : 96;
            f32x4 sA[9], sB[9];
            const LAS unsigned char* kbp = lds + (kst + 8 * (fr >> 2) + (fr & 3)) * KP + fq * 16;
#pragma unroll
            for (int c = 0; c < 9; ++c) {
                const LAS unsigned char* ka = kbp + c * 32 * KP;
                const bf16x8 a0 = *(const LAS bf16x8*)ka, a1 = *(const LAS bf16x8*)(ka + 64);
                const bf16x8 b0 = *(const LAS bf16x8*)(ka + 4 * KP), b1 = *(const LAS bf16x8*)(ka + 4 * KP + 64);
                f32x4 z = (f32x4){0.f, 0.f, 0.f, 0.f};
                sA[c] = __builtin_amdgcn_mfma_f32_16x16x32_bf16(a0, Q0, z, 0, 0, 0); sA[c] = __builtin_amdgcn_mfma_f32_16x16x32_bf16(a1, Q1, sA[c], 0, 0, 0);
                sB[c] = __builtin_amdgcn_mfma_f32_16x16x32_bf16(b0, Q0, z, 0, 0, 0); sB[c] = __builtin_amdgcn_mfma_f32_16x16x32_bf16(b1, Q1, sB[c], 0, 0, 0);
            }
            float mx = sink2;
            const int klo = r, khi = r + 256, kmin = 128 - blk * 128, kmax = SEQ + 128 - blk * 128;
#pragma unroll
            for (int c = 0; c < 9; ++c) {
                if (c == 0 || c == 8 || edge) {
#pragma unroll
                    for (int jj = 0; jj < 4; ++jj) {
                        const int ka = kst + 32 * c + 8 * fq + jj, kb = ka + 4;
                        const bool va = (ka >= klo) && (ka <= khi) && (ka >= kmin) && (ka < kmax), vb = (kb >= klo) && (kb <= khi) && (kb >= kmin) && (kb < kmax);
                        sA[c][jj] = va ? sA[c][jj] * SC : -1e30f; sB[c][jj] = vb ? sB[c][jj] * SC : -1e30f;
                        mx = fmaxf(mx, fmaxf(sA[c][jj], sB[c][jj]));
                    }
                } else {
#pragma unroll
                    for (int jj = 0; jj < 4; ++jj) { sA[c][jj] *= SC; sB[c][jj] *= SC; mx = fmaxf(mx, fmaxf(sA[c][jj], sB[c][jj])); }
                }
            }
            mx = fmaxf(mx, __shfl_xor(mx, 16)); mx = fmaxf(mx, __shfl_xor(mx, 32));
            float sum = 0.f;
#pragma unroll
            for (int c = 0; c < 9; ++c)
#pragma unroll
                for (int jj = 0; jj < 4; ++jj) { sA[c][jj] = __builtin_amdgcn_exp2f(sA[c][jj] - mx); sB[c][jj] = __builtin_amdgcn_exp2f(sB[c][jj] - mx); sum += sA[c][jj] + sB[c][jj]; }
            sum += __shfl_xor(sum, 16); sum += __shfl_xor(sum, 32);
            const float inv = 1.0f / (sum + __builtin_amdgcn_exp2f(sink2 - mx));
            f32x4 o[4];
#pragma unroll
            for (int dt = 0; dt < 4; ++dt) o[dt] = (f32x4){0.f, 0.f, 0.f, 0.f};
            const LAS unsigned char* vbp = lds + OFF_V + fr * VP + (kst + 8 * fq) * 2;
#pragma unroll
            for (int c = 0; c < 9; ++c) {
                const bf16x8 pf = as_bf16x8(pack_p(sA[c], sB[c]));
#pragma unroll
                for (int dt = 0; dt < 4; ++dt) {
                    const bf16x8 vf = *(const LAS bf16x8*)(vbp + dt * 16 * VP + c * 64);
                    o[dt] = __builtin_amdgcn_mfma_f32_16x16x32_bf16(vf, pf, o[dt], 0, 0, 0);
                }
            }
            bf16* op = AO + mq * 512 + h * 64 + 4 * fq;
#pragma unroll
            for (int dt = 0; dt < 4; ++dt) { const f32x4 ov = o[dt] * inv; u32x2 w; w.x = pk2(ov[0], ov[1]); w.y = pk2(ov[2], ov[3]); *(GAS u32x2*)(op + 16 * dt) = w; }
        }
    }
    __syncthreads();
}
__device__ __forceinline__ void pool_run(const bf16* PROJ, bf16* PL, int m0, int T, int lane) {
    const int h = 1 << (lane >> 4), t0 = m0 & (SEQ - 1);
    const bf16* base = PROJ + (size_t)(m0 - t0) * INW + C_P + lane * 8;
    bf16* outp = PL + (size_t)m0 * 512 + lane * 8;
    float s[8];
#pragma unroll
    for (int k = 0; k < 8; ++k) s[k] = 0.f;
#pragma unroll
    for (int j = 0; j < 16; ++j) {
        const int r = t0 - h + j; const bool ok = (j < 2 * h) && (r >= 0) && (r < SEQ);
        u32x4 w = *(const GAS u32x4*)(base + (size_t)(ok ? r : t0) * INW);
        if (!ok) w = (u32x4){0u, 0u, 0u, 0u};
        float x[8]; unpack8(w, x);
#pragma unroll
        for (int k = 0; k < 8; ++k) s[k] += x[k];
    }
    for (int i0 = 0; i0 < T; i0 += 4) {
        u32x4 ws[4], wa[4], wr[4];
#pragma unroll
        for (int i = 0; i < 4; ++i) {
            const int t = t0 + i0 + i, ra = t + h, rr = t - h;
            ws[i] = *(const GAS u32x4*)(base + (size_t)t * INW);
            wa[i] = *(const GAS u32x4*)(base + (size_t)(ra < SEQ ? ra : t) * INW); if (ra >= SEQ) wa[i] = (u32x4){0u, 0u, 0u, 0u};
            wr[i] = *(const GAS u32x4*)(base + (size_t)(rr >= 0 ? rr : t) * INW); if (rr < 0) wr[i] = (u32x4){0u, 0u, 0u, 0u};
        }
#pragma unroll
        for (int i = 0; i < 4; ++i) {
            const int t = t0 + i0 + i;
            const int lo = (t - h) > 0 ? (t - h) : 0, hi = (t + h) < SEQ ? (t + h) : SEQ;
            const float ic = 1.0f / (float)(hi - lo);
            float x[8], o[8]; unpack8(ws[i], x);
#pragma unroll
            for (int k = 0; k < 8; ++k) o[k] = s[k] * ic - x[k];
            *(GAS u32x4*)(outp + (size_t)(i0 + i) * 512) = pack8(o);
            float xa[8], xr[8]; unpack8(wa[i], xa); unpack8(wr[i], xr);
#pragma unroll
            for (int k = 0; k < 8; ++k) s[k] += xa[k] - xr[k];
        }
    }
}
__device__ __forceinline__ void final_phase(float* out, const bf16* hb, const float* ssq, const float* gfin, int gw, int NGW, int lane, int m_end) {
    const GAS f32x4* gr = (const GAS f32x4*)gfin + 2 * lane;
    const f32x4 g0 = gr[0], g1 = gr[1], g2 = gr[128], g3 = gr[129];
    for (int m = gw; m < m_end; m += 2 * NGW) {
        f32x4 p[2]; u32x4 hv[2][2];
#pragma unroll
        for (int r = 0; r < 2; ++r) { const int mm = m + r * NGW;
            const GAS f32x4* sp = (const GAS f32x4*)(ssq + (size_t)mm * 16) + (lane & 3);
            p[r] = sp[0];
            const GAS u32x4* hr = (const GAS u32x4*)(hb + (size_t)mm * D) + lane; hv[r][0] = hr[0]; hv[r][1] = hr[64]; }
#pragma unroll
        for (int r = 0; r < 2; ++r) { const int mm = m + r * NGW;
            float q = (p[r][0] + p[r][1]) + (p[r][2] + p[r][3]); q += __shfl_xor(q, 1); q += __shfl_xor(q, 2);
            const float rs = rsqrtf(q * (1.0f / D) + 1e-6f);
            GAS f32x4* xr = (GAS f32x4*)(out + (size_t)mm * D) + 2 * lane;
            float x[8]; unpack8(hv[r][0], x);
            xr[0] = (f32x4){x[0], x[1], x[2], x[3]} * rs * g0; xr[1] = (f32x4){x[4], x[5], x[6], x[7]} * rs * g1;
            unpack8(hv[r][1], x);
            xr[128] = (f32x4){x[0], x[1], x[2], x[3]} * rs * g2; xr[129] = (f32x4){x[4], x[5], x[6], x[7]} * rs * g3; }
    }
}

#define RLX_AGENT __ATOMIC_RELAXED, __HIP_MEMORY_SCOPE_AGENT
#define XB_TMO      128
#define XB_XCNT(j)  (256  + 64 * (j))
#define XB_XSUB(j)  (1280 + 64 * (j))
#define XB_XGEN(j)  (2304 + 64 * (j))
#define XB_TOP      3328
#define XB_TOPGEN   3392
#define XCD_BAR_WORDS 3456
#define XB_SPIN_CAP (1u << 18)

__device__ __forceinline__ unsigned xb_ld(unsigned* p)              { return __hip_atomic_load(p, __ATOMIC_RELAXED, __HIP_MEMORY_SCOPE_AGENT); }
__device__ __forceinline__ unsigned xb_add(unsigned* p, unsigned v) { return __hip_atomic_fetch_add(p, v, __ATOMIC_RELAXED, __HIP_MEMORY_SCOPE_AGENT); }
__device__ __forceinline__ unsigned xb_xcc_id() { return (unsigned)__builtin_amdgcn_s_getreg((3 << 11) | 20) & 0xFu; }
#define XB_SPIN(cond, bar) do { unsigned _sp = 0; while (cond) { __builtin_amdgcn_s_sleep(1); \
    if ((++_sp & 255u) == 0u) { if (xb_ld(&(bar)[XB_TMO])) break; if (_sp > XB_SPIN_CAP) { atomicAdd(&(bar)[XB_TMO], 1u); break; } } } } while (0)

struct XcdBarrier {
    unsigned* bar; unsigned x;
    volatile LAS unsigned* st;
};

__device__ __forceinline__ XcdBarrier xcd_barrier_post(unsigned* bar, volatile LAS unsigned* st) {
    XcdBarrier b; b.bar = bar; b.x = xb_xcc_id(); b.st = st;
    if (threadIdx.x == 0) (void)xb_add(&bar[XB_XCNT(b.x)], 1u);
    return b;
}
__device__ __forceinline__ void xcd_barrier_complete(unsigned* bar, unsigned x, unsigned& nloc, unsigned& nx) {
    const unsigned G = gridDim.x * gridDim.y * gridDim.z;
    unsigned sum, cnt, mine, sp = 0u;
    for (;;) {
        sum = 0u; cnt = 0u; mine = 0u;
#pragma unroll
        for (unsigned j = 0; j < 16; ++j) { const unsigned c = xb_ld(&bar[XB_XCNT(j)]); sum += c; cnt += (c > 0u) ? 1u : 0u; mine = (j == x) ? c : mine; }
        if (sum == G) break;
        __builtin_amdgcn_s_sleep(1);
        if ((++sp & 255u) == 0u) { if (xb_ld(&bar[XB_TMO])) break; if (sp > XB_SPIN_CAP) { atomicAdd(&bar[XB_TMO], 1u); break; } }
    }
    nloc = mine > 0u ? mine : 1u; nx = cnt > 0u ? cnt : 1u;
}

__device__ __forceinline__ void xcd_barrier(const XcdBarrier& b) {
    asm volatile("s_waitcnt vmcnt(0)" ::: "memory");
    __syncthreads();
    if (threadIdx.x == 0) {
        unsigned* bar = b.bar;
        __builtin_amdgcn_s_waitcnt(0);
        unsigned nloc = b.st[0], nx = b.st[1];
        if (nloc == 0u) { xcd_barrier_complete(bar, b.x, nloc, nx); b.st[0] = nloc; b.st[1] = nx; }
        const unsigned old = xb_add(&bar[XB_XSUB(b.x)], 1u);
        const unsigned gen = old / nloc;
        if (old + 1u == (gen + 1u) * nloc) {
            __builtin_amdgcn_fence(__ATOMIC_RELEASE, "agent");
            asm volatile("s_waitcnt vmcnt(0)" ::: "memory");
            const unsigned og = xb_add(&bar[XB_TOP], 1u);
            const unsigned tg = og / nx;
            if (og + 1u == (tg + 1u) * nx) xb_add(&bar[XB_TOPGEN], 1u);
            else XB_SPIN(xb_ld(&bar[XB_TOPGEN]) == tg, bar);
            __builtin_amdgcn_fence(__ATOMIC_ACQUIRE, "agent");
            xb_add(&bar[XB_XGEN(b.x)], 1u);
            asm volatile("s_waitcnt vmcnt(0)" ::: "memory");
        } else {
            XB_SPIN(xb_ld(&bar[XB_XGEN(b.x)]) == gen, bar);
            __builtin_amdgcn_fence(__ATOMIC_ACQUIRE, "agent");
            asm volatile("s_waitcnt vmcnt(0)" ::: "memory");
        }
    }
    __syncthreads();
}

#define XB_LSUB(j)  (3456 + 64 * (j))
#define XB_LGEN(j)  (4480 + 64 * (j))
#define XB_TAB      5504
__device__ __forceinline__ void xcd_local_barrier(const XcdBarrier& b) {
    asm volatile("s_waitcnt vmcnt(0)" ::: "memory");
    __syncthreads();
    if (threadIdx.x == 0) {
        unsigned* bar = b.bar;
        __builtin_amdgcn_s_waitcnt(0);
        const unsigned nloc = b.st[0];
        const unsigned old = xb_add(&bar[XB_LSUB(b.x)], 1u);
        const unsigned gen = old / nloc;
        if (old + 1u == (gen + 1u) * nloc) xb_add(&bar[XB_LGEN(b.x)], 1u);
        else XB_SPIN(xb_ld(&bar[XB_LGEN(b.x)]) == gen, bar);
        __builtin_amdgcn_fence(__ATOMIC_ACQUIRE, "agent");
        asm volatile("s_waitcnt vmcnt(0)" ::: "memory");
    }
    __syncthreads();
}
#define XB_PSUB(j)     (5760 + 64 * (j))
#define XB_PGEN(j)     (6784 + 64 * (j))
#define XB_PTOP(p)     (7808 + 64 * (p))
#define XB_PTOPGEN(p)  (8064 + 64 * (p))
__device__ __forceinline__ void xcd_pair_barrier(const XcdBarrier& b, unsigned pair) {
    asm volatile("s_waitcnt vmcnt(0)" ::: "memory");
    __syncthreads();
    if (threadIdx.x == 0) {
        unsigned* bar = b.bar;
        __builtin_amdgcn_s_waitcnt(0);
        const unsigned nloc = b.st[0];
        const unsigned old = xb_add(&bar[XB_PSUB(b.x)], 1u);
        const unsigned gen = old / nloc;
        if (old + 1u == (gen + 1u) * nloc) {
            __builtin_amdgcn_fence(__ATOMIC_RELEASE, "agent");
            asm volatile("s_waitcnt vmcnt(0)" ::: "memory");
            const unsigned og = xb_add(&bar[XB_PTOP(pair)], 1u);
            const unsigned tg = og / 2u;
            if (og + 1u == (tg + 1u) * 2u) xb_add(&bar[XB_PTOPGEN(pair)], 1u);
            else XB_SPIN(xb_ld(&bar[XB_PTOPGEN(pair)]) == tg, bar);
            __builtin_amdgcn_fence(__ATOMIC_ACQUIRE, "agent");
            xb_add(&bar[XB_PGEN(b.x)], 1u);
            asm volatile("s_waitcnt vmcnt(0)" ::: "memory");
        } else {
            XB_SPIN(xb_ld(&bar[XB_PGEN(b.x)]) == gen, bar);
            __builtin_amdgcn_fence(__ATOMIC_ACQUIRE, "agent");
            asm volatile("s_waitcnt vmcnt(0)" ::: "memory");
        }
    }
    __syncthreads();
}
constexpr int RS_OFF = 131072 + 1024, GB_OFF = RS_OFF + 4096;
static_assert(GB_OFF + 8192 <= LDS_BYTES, "spare LDS");
template <class Sched> __device__ __forceinline__ void rstd_setup(LAS unsigned char* lds, const float* ssq, const Sched& S) {
    LAS float* tab = (LAS float*)(lds + RS_OFF);
    int tid = threadIdx.x; asm volatile("" : "+v"(tid));
    int prev = -1; pg8::Unit u;
    for (int i = 0; S.next(i, u); ++i) {
        if (u.pm == prev) continue;
        prev = u.pm;
        const GAS f32x4* sp = (const GAS f32x4*)(ssq + (size_t)(u.pm * 256 + (tid >> 1)) * 16) + (tid & 1) * 2;
        const f32x4 p = sp[0] + sp[1];
        float q = (p[0] + p[1]) + (p[2] + p[3]); q += __shfl_xor(q, 1);
        if (!(tid & 1)) tab[((u.pm >> 3) & 3) * 256 + (tid >> 1)] = rsqrtf(q * (1.0f / D) + 1e-6f);
    }
    __syncthreads();
}

#ifndef MK_N_LAUNCHES
#define MK_N_LAUNCHES 1
#endif
#ifndef REP_PREP
#define REP_PREP 1
#endif
#ifndef REP_PREP_PARTS
#define REP_PREP_PARTS 15
#endif
#ifndef REP_UP
#define REP_UP 1
#endif
#ifndef REP_IN
#define REP_IN 1
#endif
#ifndef REP_ATT
#define REP_ATT 1
#endif
#ifndef REP_DOWN
#define REP_DOWN 1
#endif
#ifndef REP_OUT
#define REP_OUT 1
#endif
#ifndef REP_UPNULL
#define REP_UPNULL 0
#endif
#ifndef REP_BR
#define REP_BR 1
#endif
constexpr int NPH = 2 + 8 * DEPTH;
__global__ void __launch_bounds__(NTHR, 2) mk_fwd(Args a) {
    extern __shared__ __attribute__((aligned(16))) unsigned char lds_raw[];
    LAS unsigned char* lds = (LAS unsigned char*)lds_raw;
    cg::grid_group grid = cg::this_grid();
    const int tid = threadIdx.x, lane = tid & 63, wave = __builtin_amdgcn_readfirstlane(tid >> 6);
    const int G = gridDim.x, bx = blockIdx.x;
    const int gw = bx * NWAVES + wave, NGW = G * NWAVES, gtid = bx * NTHR + tid, NT = G * NTHR;
    unsigned char* ws = a.ws;
    volatile LAS unsigned* MISC = (volatile LAS unsigned*)(lds + 131072 + 320);
    if (tid < 32) MISC[tid] = 0u;
    __syncthreads();
    XcdBarrier bar = xcd_barrier_post((unsigned*)(ws + WS_CTL) + 1024, MISC + 8);
    if (tid == 0) __hip_atomic_store(&bar.bar[XB_TAB + bx], bar.x + 1u, __ATOMIC_RELAXED, __HIP_MEMORY_SCOPE_AGENT);
    if (a.lo < 0) grid.sync();
    int ph = 0;
#define PH_ON (ph >= a.lo && ph < a.hi)
#define PH_END do { if (PH_ON && ph + 1 < a.hi) xcd_barrier(bar); ++ph; } while (0)

    if (PH_ON) for (int rep = 0; rep < REP_PREP; ++rep) { if (rep) xcd_barrier(bar); prep_phase(a, lds, gw, NGW, lane, gtid, NT, rep ? REP_PREP_PARTS : 15); }
    PH_END;
    bool local_ok;
    {
        if (tid == 0) MISC[16] = 1u;
        __syncthreads();
        bool okc = true;
        if (tid < G && tid < NTHR) { const unsigned v = xb_ld(&bar.bar[XB_TAB + tid]), w = xb_ld(&bar.bar[XB_TAB + (tid & 7)]); okc = (v == w) && (v != 0u);
            if (tid < 8) { for (int u2 = 0; u2 < 8; ++u2) if (u2 != tid && xb_ld(&bar.bar[XB_TAB + u2]) == v) okc = false; } }
        if (!okc) MISC[16] = 0u;
        __syncthreads();
        local_ok = (MISC[16] != 0u) && (G == 256) && (MISC[8] == 32u) && (a.hi - a.lo == NPH);
    }
#define PH_END_P do { if (PH_ON && ph + 1 < a.hi) { if (local_ok) xcd_pair_barrier(bar, (unsigned)(bx & 7) >> 1); else xcd_barrier(bar); } ++ph; } while (0)
#define PH_END_L(loc) do { if (PH_ON && ph + 1 < a.hi) { if (local_ok && (loc)) xcd_local_barrier(bar); else xcd_barrier(bar); } ++ph; } while (0)
#pragma unroll 1
    for (int l = 0; l < DEPTH; ++l) {
        unsigned char* wsl = a.ws; asm volatile("" : "+s"(wsl));
        unsigned char* wl = wsl + WS_W + (size_t)l * LW;
        float* ssq = (float*)(wsl + WS_SSQ);
        bf16* HB = (bf16*)(wsl + WS_HB); bf16* AO = (bf16*)(wsl + WS_AOPL); bf16* PL = (bf16*)(wsl + WS_AOPL + 32 * MiB);
        bf16* R1 = (bf16*)(wsl + WS_R1); bf16* Z = (bf16*)(wsl + WS_Z);
        const float* tab = (const float*)(wsl + WS_TAB);
#pragma unroll 1
        for (int f = 0; f < 2; ++f) {
            if (PH_ON) for (int rep = 0; rep < REP_UP; ++rep) {   if (rep) xcd_barrier(bar);
                pg8::Gemm g{HB, (const bf16*)(wl + (f ? LW_UP2 : LW_UP1)), M, NUP, D}; pg8::StaticOrder S; S.init(M, NUP, G, bx);
                rstd_setup(lds, ssq, S);
                pg8::EpiUp E{R1, (const LAS float*)(lds + RS_OFF), FF, G_GAP / 2};
                pg8::gemm_phase<pg8::EpiUp, pg8::StaticOrder, true, true>(lds, g, S, E);
            }
            if (PH_ON) for (int rep = 0; rep < REP_UPNULL; ++rep) {   xcd_barrier(bar);
                pg8::Gemm g{HB, (const bf16*)(wl + (f ? LW_UP2 : LW_UP1)), M, NUP, D}; pg8::StaticOrder S; S.init(M, NUP, G, bx);
                pg8::EpiNull E{(float*)(ws + WS_CTL + 32768)};
                pg8::gemm_phase<pg8::EpiNull, pg8::StaticOrder, true, true>(lds, g, S, E);
            }
            PH_END_L(true);
            if (PH_ON) for (int rep = 0; rep < REP_DOWN; ++rep) {   if (rep) xcd_barrier(bar);
                pg8::Gemm g{R1, (const bf16*)(wl + (f ? LW_DN2 : LW_DN1)), M, D, FF, G_GAP}; pg8::StaticOrder S; S.init(M, D, G, bx);
                pg8::EpiRes E{(l == 0 && f == 0 && rep == 0) ? a.in[0] : nullptr, HB, ssq, rep ? 0.f : 0.5f};
                pg8::gemm_phase<pg8::EpiRes, pg8::StaticOrder, true, true>(lds, g, S, E);
            }
            PH_END_L(true);
            if (f == 0) {
                if (PH_ON) for (int rep = 0; rep < REP_IN; ++rep) {   if (rep) xcd_barrier(bar);
                    pg8::Gemm g{HB, (const bf16*)(wl + LW_IN), M, INW, D}; pg8::StaticOrder S; S.init(M, INW, G, bx);
                    { int t_ = threadIdx.x; asm volatile("" : "+v"(t_)); const f32x4 bq = *(const GAS f32x4*)(a.in[7] + l * 2 * D + 4 * t_); *(LAS f32x4*)(lds + GB_OFF + 16 * t_) = bq; }
                    rstd_setup(lds, ssq, S);
                    pg8::EpiIn E{R1, (const LAS float*)(lds + RS_OFF), (const LAS float*)(lds + GB_OFF), INW, C_GA, 0};
                    pg8::gemm_phase<pg8::EpiIn, pg8::StaticOrder, true, true>(lds, g, S, E);
                }
                PH_END_P;
                if (PH_ON) for (int rep = 0; rep < REP_ATT; ++rep) {   if (rep) xcd_barrier(bar);
                    attn_phase(lds, R1, AO, tab, a.in[8] + l * 8, G, bx, local_ok);
                    {
                        const int run0 = local_ok ? (bx & 7) * 256 + (bx >> 3) * NWAVES + wave : gw, rstep = local_ok ? M : NGW;
                        for (int run = run0; run < M / 16; run += rstep) pool_run(R1, PL, run * 16, 16, lane);
                    }
                }
                PH_END_L(true);
                if (PH_ON) for (int rep = 0; rep < REP_BR; ++rep) {   if (rep) xcd_barrier(bar);
                    { pg8::Gemm g{AO, (const bf16*)(wl + LW_BA), M, D, 512}; pg8::StaticOrder S; S.init(M, D, G, bx);
                      pg8::EpiBr<true> E{R1, Z, INW, C_GA};
                      pg8::gemm_phase<pg8::EpiBr<true>, pg8::StaticOrder, true, true>(lds, g, S, E); }
                    { pg8::Gemm g{PL, (const bf16*)(wl + LW_BP), M, D, 512}; pg8::StaticOrder S; S.init(M, D, G, bx);
                      pg8::EpiBr<false> E{R1, Z, INW, C_GB};
                      pg8::gemm_phase<pg8::EpiBr<false>, pg8::StaticOrder, true, true>(lds, g, S, E); }
                }
                PH_END_L(true);
                if (PH_ON) for (int rep = 0; rep < REP_OUT; ++rep) {   if (rep) xcd_barrier(bar);
                    pg8::Gemm g{Z, (const bf16*)(wl + LW_OUT), M, D, D}; pg8::StaticOrder S; S.init(M, D, G, bx);
                    pg8::EpiRes E{nullptr, HB, ssq, rep ? 0.f : 1.0f};
                    pg8::gemm_phase<pg8::EpiRes, pg8::StaticOrder, true, true>(lds, g, S, E);
                }
                PH_END_P;
            }
        }
    }
    if (PH_ON) {
        const int f0 = local_ok ? (bx & 7) * 4096 + (bx >> 3) * NWAVES + wave : gw, fs = local_ok ? 256 : NGW, fe = local_ok ? (bx & 7) * 4096 + 4096 : M;
        final_phase(a.out, (const bf16*)(ws + WS_HB), (const float*)(ws + WS_SSQ), a.in[18], f0, fs, lane, fe);
    }
    PH_END;
}

extern "C" void kernel_launch(void* const* d_in, const int* in_sizes, int n_in, void* d_out, int out_size, void* d_ws, size_t ws_size, hipStream_t stream) {
    static int grid = 0;
    if (grid == 0) {
        if (n_in != 19 || out_size != M * D || ws_size < WS_END) { fprintf(stderr, "kernel_launch: unexpected shapes (n_in %d, out %d, ws %zu)\n", n_in, out_size, ws_size); grid = -1; return; }
        int dev = 0, cus = 0, per_cu = 0;
        (void)hipGetDevice(&dev); (void)hipDeviceGetAttribute(&cus, hipDeviceAttributeMultiprocessorCount, dev);
        if (hipFuncSetAttribute((const void*)mk_fwd, hipFuncAttributeMaxDynamicSharedMemorySize, LDS_BYTES) != hipSuccess) { fprintf(stderr, "kernel_launch: hipFuncSetAttribute failed\n"); grid = -1; return; }
        if (hipOccupancyMaxActiveBlocksPerMultiprocessor(&per_cu, (const void*)mk_fwd, NTHR, LDS_BYTES) != hipSuccess || per_cu < 1) { fprintf(stderr, "kernel_launch: occupancy query failed (%d)\n", per_cu); per_cu = 1; }
        (void)hipGetLastError();
        grid = cus * 1;
        fprintf(stderr, "kernel_launch: cus %d per_cu %d grid %d\n", cus, per_cu, grid);
    }
    if (grid < 0) return;
    if (hipMemsetAsync((char*)d_ws + WS_CTL, 0, 65536, stream) != hipSuccess) { fprintf(stderr, "kernel_launch: hipMemsetAsync failed\n"); return; }
    Args a{};
    for (int i = 0; i < 19; ++i) a.in[i] = (const float*)d_in[i];
    a.out = (float*)d_out; a.ws = (unsigned char*)d_ws;
#if MK_N_LAUNCHES == 1
    a.lo = 0; a.hi = NPH;
    void* args[] = {&a};
    hipError_t e = hipLaunchCooperativeKernel((const void*)mk_fwd, dim3(grid), dim3(NTHR), args, LDS_BYTES, stream);
    if (e != hipSuccess) fprintf(stderr, "kernel_launch: cooperative launch failed: %s (grid %d)\n", hipGetErrorString(e), grid);
#else
    for (int ph = 0; ph < NPH; ++ph) { a.lo = ph; a.hi = ph + 1; hipLaunchKernelGGL(mk_fwd, dim3(grid), dim3(NTHR), LDS_BYTES, stream, a); }
#endif
}
```
